# Optimizing an MI355X kernel written in HIP

```python
import math
import jax, jax.numpy as jnp
from jax import lax
import numpy as np

D_MODEL = 1024
BATCH = 16
SEQ = 2048
DEPTH = 1
DEC_BATCH = 128
DEC_SEQ = 8
PAST_LEN = 16384
PAGE_SIZE = 128

ATTN_HEADS = 8
ATTN_KV_HEADS = 2
GROUP = ATTN_HEADS // ATTN_KV_HEADS
HEAD_DIM = 64
ATTN_WIDTH = ATTN_HEADS * HEAD_DIM
KV_WIDTH = ATTN_KV_HEADS * HEAD_DIM
WINDOW = 128
ATTN_SCALE = HEAD_DIM ** -0.5
HGRN_HEADS = 4
HGRN_DK = 128
HGRN_DV = (D_MODEL - ATTN_WIDTH) // HGRN_HEADS
HGRN_KW = HGRN_HEADS * HGRN_DK
HGRN_VW = HGRN_HEADS * HGRN_DV
CHUNK = 64
D_MIX = ATTN_WIDTH + HGRN_VW
D_IN = ATTN_WIDTH + 2 * KV_WIDTH + 2 * HGRN_KW + 2 * HGRN_VW
D_FF = ((8 * D_MODEL // 3 + 127) // 128) * 128
ALPHA = (2.0 * DEPTH) ** 0.25
BETA = (8.0 * DEPTH) ** -0.25
LN_EPS = 1e-5
RMS_EPS = 1e-6

kernel_name = "hymba_hgrn2_swa_sink_macaron_deepnorm_step"


def _layer_norm(x, g, b):
    xf = x.astype(jnp.float32)
    mu = jnp.mean(xf, axis=-1, keepdims=True)
    var = jnp.mean(jnp.square(xf - mu), axis=-1, keepdims=True)
    y = (xf - mu) * lax.rsqrt(var + LN_EPS) * g.astype(jnp.float32) + b.astype(jnp.float32)
    return y.astype(x.dtype)


def _rms_norm(x, g):
    xf = x.astype(jnp.float32)
    return xf * lax.rsqrt(jnp.mean(jnp.square(xf), axis=-1, keepdims=True) + RMS_EPS) * g.astype(jnp.float32)


def _swiglu(x, w13, w2):
    gate, up = jnp.split(x @ w13, 2, axis=-1)
    return (jax.nn.silu(gate) * up) @ w2


def _alibi_slopes():
    h = jnp.arange(1, ATTN_HEADS + 1, dtype=jnp.float32)
    return jnp.exp2(-8.0 * h / ATTN_HEADS).reshape(ATTN_KV_HEADS, GROUP)


def _sink_attend(s, sinks, v, eq):
    sk = sinks.astype(jnp.float32)[:, :, None]
    m = jnp.maximum(jnp.max(s, axis=-1), sk)
    p = jnp.exp(s - m[..., None])
    denom = jnp.sum(p, axis=-1) + jnp.exp(sk - m)
    p = p / denom[..., None]
    return jnp.einsum(eq, p, v.astype(jnp.float32))


def _swa_prompt(q, k, v, sinks):
    B, L = q.shape[:2]
    nb = L // WINDOW
    qb = q.reshape(B, nb, WINDOW, ATTN_KV_HEADS, GROUP, HEAD_DIM)

    def band(a):
        ap = jnp.pad(a, ((0, 0), (WINDOW, 0), (0, 0), (0, 0)))
        ap = ap.reshape(B, nb + 1, WINDOW, ATTN_KV_HEADS, HEAD_DIM)
        return jnp.concatenate([ap[:, :-1], ap[:, 1:]], axis=2)

    kb, vb = band(k), band(v)
    s = jnp.einsum('bnqhgd,bnkhd->bnhgqk', qb, kb, preferred_element_type=jnp.float32) * ATTN_SCALE
    qi = jnp.arange(WINDOW)
    kc = jnp.arange(2 * WINDOW)
    dist = qi[:, None] + WINDOW - kc[None, :]
    key_pos = (jnp.arange(nb)[:, None] - 1) * WINDOW + kc[None, :]
    mask = ((dist >= 0) & (dist < WINDOW))[None] & (key_pos >= 0)[:, None, :]
    bias = -_alibi_slopes()[:, :, None, None] * dist.astype(jnp.float32)
    s = jnp.where(mask[None, :, None, None], s + bias, -jnp.inf)
    o = _sink_attend(s, sinks, vb, 'bnhgqk,bnkhd->bnqhgd')
    return o.reshape(B, L, ATTN_WIDTH), k[:, -WINDOW:], v[:, -WINDOW:]


def _swa_sample(q, k, v, buf_k, buf_v, sinks):
    B, T = q.shape[:2]
    wb = buf_k.shape[1]
    qg = q.reshape(B, T, ATTN_KV_HEADS, GROUP, HEAD_DIM)
    kk = jnp.concatenate([buf_k.astype(k.dtype), k], axis=1)
    vv = jnp.concatenate([buf_v.astype(v.dtype), v], axis=1)
    s = jnp.einsum('bqhgd,bkhd->bhgqk', qg, kk, preferred_element_type=jnp.float32) * ATTN_SCALE
    dist = wb + jnp.arange(T)[:, None] - jnp.arange(wb + T)[None, :]
    mask = (dist >= 0) & (dist < WINDOW)
    bias = -_alibi_slopes()[:, :, None, None] * dist.astype(jnp.float32)
    s = jnp.where(mask, s + bias, -jnp.inf)
    o = _sink_attend(s, sinks, vv, 'bhgqk,bkhd->bqhgd')
    return o.reshape(B, T, ATTN_WIDTH), kk[:, -wb:], vv[:, -wb:]


def _hgrn2(q, k, v, logf, S0):
    B, L = q.shape[:2]
    C = CHUNK if L % CHUNK == 0 else L
    nc = L // C

    def chunks(a):
        return a.astype(jnp.float32).reshape(B, nc, C, *a.shape[2:]).swapaxes(0, 1)

    causal = jnp.tril(jnp.ones((C, C), dtype=bool))[None, :, :, None, None]

    def step(S, xs):
        qc, kc, vc, gc = xs
        b = jnp.cumsum(gc, axis=1)
        o = jnp.einsum('bthk,bhkv->bthv', qc * jnp.exp(b), S)
        dec = jnp.exp(jnp.where(causal, b[:, :, None] - b[:, None, :], -jnp.inf))
        a = jnp.einsum('bthk,bshk,btshk->bhts', qc, kc, dec)
        o = o + jnp.einsum('bhts,bshv->bthv', a, vc)
        b_last = b[:, -1]
        S = jnp.exp(b_last)[..., None] * S + jnp.einsum(
            'bshk,bshv->bhkv', kc * jnp.exp(b_last[:, None] - b), vc)
        return S, o

    S, o = lax.scan(step, S0.astype(jnp.float32), (chunks(q), chunks(k), chunks(v), chunks(logf)))
    return o.swapaxes(0, 1).reshape(B, L, HGRN_HEADS, HGRN_DV), S


def _mixer(h, S0, buf_k, buf_v, lb, w_in, attn_sink, attn_norm_g, hgrn_norm_g, w_out):
    B, L, _ = h.shape
    offs = [ATTN_WIDTH, ATTN_WIDTH + KV_WIDTH, ATTN_WIDTH + 2 * KV_WIDTH,
            ATTN_WIDTH + 2 * KV_WIDTH + HGRN_KW, ATTN_WIDTH + 2 * KV_WIDTH + 2 * HGRN_KW,
            ATTN_WIDTH + 2 * KV_WIDTH + 2 * HGRN_KW + HGRN_VW]
    qa, ka, va, hq, hf, hi, hg = jnp.split(h @ w_in, offs, axis=-1)
    qa = qa.reshape(B, L, ATTN_HEADS, HEAD_DIM)
    ka = ka.reshape(B, L, ATTN_KV_HEADS, HEAD_DIM)
    va = va.reshape(B, L, ATTN_KV_HEADS, HEAD_DIM)
    sinks = attn_sink.reshape(ATTN_KV_HEADS, GROUP)
    if buf_k is None:
        oa, nk, nv = _swa_prompt(qa, ka, va, sinks)
    else:
        oa, nk, nv = _swa_sample(qa, ka, va, buf_k, buf_v, sinks)
    oa = _rms_norm(oa, attn_norm_g)
    fq = jax.nn.silu(hq.astype(jnp.float32)).reshape(B, L, HGRN_HEADS, HGRN_DK)
    f = lb + (1.0 - lb) * jax.nn.sigmoid(hf.astype(jnp.float32))
    logf = jnp.log(f).reshape(B, L, HGRN_HEADS, HGRN_DK)
    kin = (1.0 - f).reshape(B, L, HGRN_HEADS, HGRN_DK)
    vin = hi.reshape(B, L, HGRN_HEADS, HGRN_DV)
    oh, S = _hgrn2(fq, kin, vin, logf, S0)
    oh = _rms_norm(oh, hgrn_norm_g.reshape(HGRN_HEADS, HGRN_DV)).reshape(B, L, HGRN_VW)
    oh = oh * jax.nn.silu(hg.astype(jnp.float32))
    y = jnp.concatenate([oa, oh], axis=-1).astype(h.dtype) @ w_out
    return y, S, nk, nv


def _decoder_layer(x, S0, buf_k, buf_v, lb, ln1_g, ln1_b, ffn1_w13, ffn1_w2, w_in, attn_sink,
                   attn_norm_g, hgrn_norm_g, w_out, ln2_g, ln2_b, ffn2_w13, ffn2_w2, ln3_g, ln3_b):
    x = _layer_norm(ALPHA * x + 0.5 * _swiglu(x, ffn1_w13, ffn1_w2), ln1_g, ln1_b)
    y, S, nk, nv = _mixer(x, S0, buf_k, buf_v, lb, w_in, attn_sink, attn_norm_g, hgrn_norm_g, w_out)
    x = _layer_norm(ALPHA * x + y, ln2_g, ln2_b)
    x = _layer_norm(ALPHA * x + 0.5 * _swiglu(x, ffn2_w13, ffn2_w2), ln3_g, ln3_b)
    return x, S, nk, nv


def setup_inputs(seed: int = 0) -> dict:
    key = jax.random.key(seed)
    ks = jax.random.split(key, 24)
    D = D_MODEL
    wb = min(WINDOW, PAST_LEN)

    def nrm(k, shape, scale):
        return jax.random.normal(k, shape, jnp.float32) * scale

    col_scale = jnp.concatenate([
        jnp.ones((ATTN_WIDTH + KV_WIDTH,), jnp.float32),
        jnp.full((KV_WIDTH,), BETA, jnp.float32),
        jnp.ones((2 * HGRN_KW,), jnp.float32),
        jnp.full((HGRN_VW,), BETA, jnp.float32),
        jnp.ones((HGRN_VW,), jnp.float32)])
    return {
        "x_prompt": nrm(ks[0], (BATCH, SEQ, D), 1.0),
        "x_sample": nrm(ks[1], (DEC_BATCH, DEC_SEQ, D), 1.0),
        "state_hgrn": nrm(ks[2], (DEPTH, DEC_BATCH, HGRN_HEADS, HGRN_DK, HGRN_DV), 0.3),
        "cache_win_k": nrm(ks[3], (DEPTH, DEC_BATCH, wb, ATTN_KV_HEADS, HEAD_DIM), 1.0),
        "cache_win_v": nrm(ks[4], (DEPTH, DEC_BATCH, wb, ATTN_KV_HEADS, HEAD_DIM), BETA),
        "ln1_g": 1.0 + nrm(ks[5], (DEPTH, D), 0.02),
        "ln1_b": nrm(ks[6], (DEPTH, D), 0.02),
        "ffn1_w13": nrm(ks[7], (DEPTH, D, 2 * D_FF), D ** -0.5),
        "ffn1_w2": nrm(ks[8], (DEPTH, D_FF, D), BETA * D_FF ** -0.5),
        "w_in": nrm(ks[9], (DEPTH, D, D_IN), D ** -0.5) * col_scale,
        "lb_param": nrm(ks[10], (DEPTH + 1, HGRN_KW), 0.1),
        "attn_sink": nrm(ks[11], (DEPTH, ATTN_HEADS), 0.5),
        "attn_norm_g": 1.0 + nrm(ks[12], (DEPTH, ATTN_WIDTH), 0.02),
        "hgrn_norm_g": 1.0 + nrm(ks[13], (DEPTH, HGRN_VW), 0.02),
        "w_out": nrm(ks[14], (DEPTH, D_MIX, D), BETA * D_MIX ** -0.5),
        "ln2_g": 1.0 + nrm(ks[15], (DEPTH, D), 0.02),
        "ln2_b": nrm(ks[16], (DEPTH, D), 0.02),
        "ffn2_w13": nrm(ks[17], (DEPTH, D, 2 * D_FF), D ** -0.5),
        "ffn2_w2": nrm(ks[18], (DEPTH, D_FF, D), BETA * D_FF ** -0.5),
        "ln3_g": 1.0 + nrm(ks[19], (DEPTH, D), 0.02),
        "ln3_b": nrm(ks[20], (DEPTH, D), 0.02),
    }


def reference(x_prompt, x_sample, state_hgrn, cache_win_k, cache_win_v, ln1_g, ln1_b, ffn1_w13,
              ffn1_w2, w_in, lb_param, attn_sink, attn_norm_g, hgrn_norm_g, w_out, ln2_g, ln2_b,
              ffn2_w13, ffn2_w2, ln3_g, ln3_b):
    lb_all = jnp.cumsum(jax.nn.softmax(lb_param.astype(jnp.float32), axis=0), axis=0)
    xp, xs = x_prompt, x_sample
    sp_list, kp_list, vp_list, ss_list, ks_list, vs_list = [], [], [], [], [], []
    for l in range(DEPTH):
        prm = (ln1_g[l], ln1_b[l], ffn1_w13[l], ffn1_w2[l], w_in[l], attn_sink[l], attn_norm_g[l],
               hgrn_norm_g[l], w_out[l], ln2_g[l], ln2_b[l], ffn2_w13[l], ffn2_w2[l], ln3_g[l], ln3_b[l])
        S0p = jnp.zeros((xp.shape[0], HGRN_HEADS, HGRN_DK, HGRN_DV), jnp.float32)
        xp, Sp, kp, vp = _decoder_layer(xp, S0p, None, None, lb_all[l], *prm)
        xs, Ss, kq, vq = _decoder_layer(xs, state_hgrn[l], cache_win_k[l], cache_win_v[l], lb_all[l], *prm)
        sp_list.append(Sp); kp_list.append(kp); vp_list.append(vp)
        ss_list.append(Ss); ks_list.append(kq); vs_list.append(vq)
    return (xp, xs, jnp.stack(sp_list), jnp.stack(kp_list), jnp.stack(vp_list),
            jnp.stack(ss_list), jnp.stack(ks_list), jnp.stack(vs_list))
```

```cpp
#include <hip/hip_runtime.h>
#include <cmath>
namespace nv {
constexpr int D = 1024, DFF = 2816, DIN = 2816, SEQ = 2048;
constexpr float ALPHA = 1.189207115002721f;

__device__ __forceinline__ float silu_f(float x) { return x / (1.f + expf(-x)); }
__device__ __forceinline__ float sigm_f(float x) { return 1.f / (1.f + expf(-x)); }

template <int MODE>
__global__ void __launch_bounds__(256) sgemm(const float* __restrict__ A, int lda, const float* __restrict__ B, int ldb, float* C, int ldc,
                                              int M, int N, int K, const float* R, int ldr, float alpha, float scale, int upoff) {
    __shared__ float As[16][68];
    __shared__ float Bs[16][68];
    __shared__ float Bs2[(MODE == 1) ? 16 : 1][68];
    const int tid = threadIdx.x, tx = tid & 15, ty = tid >> 4;
    const int m0 = blockIdx.y * 64, n0 = blockIdx.x * 64;
    float acc[4][4], acc2[4][4];
#pragma unroll
    for (int i = 0; i < 4; ++i)
#pragma unroll
        for (int j = 0; j < 4; ++j) { acc[i][j] = 0.f; acc2[i][j] = 0.f; }
    const int ar = tid >> 2, ak = (tid & 3) * 4;
    const int bk = tid >> 4, bn = (tid & 15) * 4;
    for (int k0 = 0; k0 < K; k0 += 16) {
        const float4 av = *(const float4*)(A + (size_t)(m0 + ar) * lda + k0 + ak);
        As[ak + 0][ar] = av.x; As[ak + 1][ar] = av.y; As[ak + 2][ar] = av.z; As[ak + 3][ar] = av.w;
        const float4 bv = *(const float4*)(B + (size_t)(k0 + bk) * ldb + n0 + bn);
        Bs[bk][bn + 0] = bv.x; Bs[bk][bn + 1] = bv.y; Bs[bk][bn + 2] = bv.z; Bs[bk][bn + 3] = bv.w;
        if (MODE == 1) {
            const float4 cv = *(const float4*)(B + (size_t)(k0 + bk) * ldb + upoff + n0 + bn);
            Bs2[bk][bn + 0] = cv.x; Bs2[bk][bn + 1] = cv.y; Bs2[bk][bn + 2] = cv.z; Bs2[bk][bn + 3] = cv.w;
        }
        __syncthreads();
#pragma unroll
        for (int k = 0; k < 16; ++k) {
            float a[4], b[4], b2[4];
#pragma unroll
            for (int i = 0; i < 4; ++i) a[i] = As[k][ty * 4 + i];
#pragma unroll
            for (int j = 0; j < 4; ++j) { b[j] = Bs[k][tx * 4 + j]; if (MODE == 1) b2[j] = Bs2[k][tx * 4 + j]; }
#pragma unroll
            for (int i = 0; i < 4; ++i)
#pragma unroll
                for (int j = 0; j < 4; ++j) { acc[i][j] = fmaf(a[i], b[j], acc[i][j]); if (MODE == 1) acc2[i][j] = fmaf(a[i], b2[j], acc2[i][j]); }
        }
        __syncthreads();
    }
#pragma unroll
    for (int i = 0; i < 4; ++i) {
        const int m = m0 + ty * 4 + i;
#pragma unroll
        for (int j = 0; j < 4; ++j) {
            const int n = n0 + tx * 4 + j;
            float v = acc[i][j];
            if (MODE == 1) v = silu_f(v) * acc2[i][j];
            if (MODE == 2) v = alpha * R[(size_t)m * ldr + n] + scale * v;
            C[(size_t)m * ldc + n] = v;
        }
    }
}

__device__ __forceinline__ float block_sum_256(float v, float* red) {
#pragma unroll
    for (int o = 32; o > 0; o >>= 1) v += __shfl_xor(v, o);
    __syncthreads();
    if ((threadIdx.x & 63) == 0) red[threadIdx.x >> 6] = v;
    __syncthreads();
    return red[0] + red[1] + red[2] + red[3];
}

__global__ void __launch_bounds__(256) layernorm_rows(const float* X, float* Y, const float* __restrict__ g, const float* __restrict__ b) {
    __shared__ float red[4];
    const size_t r = blockIdx.x; const int tid = threadIdx.x;
    const float4 v = *(const float4*)(X + r * D + tid * 4);
    const float mu = block_sum_256(v.x + v.y + v.z + v.w, red) * (1.f / D);
    const float dx = v.x - mu, dy = v.y - mu, dz = v.z - mu, dw = v.w - mu;
    const float var = block_sum_256(dx * dx + dy * dy + dz * dz + dw * dw, red) * (1.f / D);
    const float rs = 1.f / sqrtf(var + 1e-5f);
    const float4 gg = *(const float4*)(g + tid * 4), bb = *(const float4*)(b + tid * 4);
    float4 o; o.x = dx * rs * gg.x + bb.x; o.y = dy * rs * gg.y + bb.y; o.z = dz * rs * gg.z + bb.z; o.w = dw * rs * gg.w + bb.w;
    *(float4*)(Y + r * D + tid * 4) = o;
}

template <bool SAMPLE>
__global__ void __launch_bounds__(256) attn_naive(const float* __restrict__ P, const float* __restrict__ ck, const float* __restrict__ cv,
                                                   const float* __restrict__ sink, const float* __restrict__ gn, float* MIX) {
    __shared__ float qs[8][64];
    __shared__ float ps[8][128];
    __shared__ float red[4];
    const int r = blockIdx.x, tid = threadIdx.x, h = tid >> 5, l32 = tid & 31, kh = h >> 2;
    const int L = SAMPLE ? 8 : SEQ; const int b = r / L, t = r % L;
    qs[h][l32] = P[(size_t)r * DIN + h * 64 + l32]; qs[h][l32 + 32] = P[(size_t)r * DIN + h * 64 + l32 + 32];
    __syncthreads();
    const float slope = exp2f(-(float)(h + 1));
    float sc[4]; float mx = -INFINITY;
#pragma unroll
    for (int i = 0; i < 4; ++i) {
        const int idx = l32 + 32 * i, dist = 127 - idx;
        const float* kp = nullptr;
        if (SAMPLE) { const int kc = 128 + t - dist; kp = (kc < 128) ? ck + ((size_t)(b * 128 + kc) * 2 + kh) * 64 : P + (size_t)(b * 8 + kc - 128) * DIN + 512 + kh * 64; }
        else { const int s = t - dist; if (s >= 0) kp = P + (size_t)(b * SEQ + s) * DIN + 512 + kh * 64; }
        float v = -INFINITY;
        if (kp) { float d = 0.f; for (int e = 0; e < 64; ++e) d = fmaf(qs[h][e], kp[e], d); v = d * 0.125f - slope * (float)dist; }
        sc[i] = v; mx = fmaxf(mx, v);
    }
#pragma unroll
    for (int o = 16; o > 0; o >>= 1) mx = fmaxf(mx, __shfl_xor(mx, o));
    const float sk = sink[h]; mx = fmaxf(mx, sk);
    float sum = 0.f;
#pragma unroll
    for (int i = 0; i < 4; ++i) { const float p = expf(sc[i] - mx); ps[h][l32 + 32 * i] = p; sum += p; }
#pragma unroll
    for (int o = 16; o > 0; o >>= 1) sum += __shfl_xor(sum, o);
    sum += expf(sk - mx);
    __syncthreads();
    float o0 = 0.f, o1 = 0.f;
    for (int idx = 0; idx < 128; ++idx) {
        const int dist = 127 - idx; const float* vp = nullptr;
        if (SAMPLE) { const int kc = 128 + t - dist; vp = (kc < 128) ? cv + ((size_t)(b * 128 + kc) * 2 + kh) * 64 : P + (size_t)(b * 8 + kc - 128) * DIN + 640 + kh * 64; }
        else { const int s = t - dist; if (s >= 0) vp = P + (size_t)(b * SEQ + s) * DIN + 640 + kh * 64; }
        if (vp) { const float p = ps[h][idx]; o0 = fmaf(p, vp[l32], o0); o1 = fmaf(p, vp[l32 + 32], o1); }
    }
    o0 /= sum; o1 /= sum;
    const float ss = block_sum_256(o0 * o0 + o1 * o1, red) * (1.f / 512.f);
    const float rs = 1.f / sqrtf(ss + 1e-6f);
    MIX[(size_t)r * D + h * 64 + l32] = o0 * rs * gn[h * 64 + l32];
    MIX[(size_t)r * D + h * 64 + l32 + 32] = o1 * rs * gn[h * 64 + l32 + 32];
}

__global__ void __launch_bounds__(512) hgrn_naive(const float* __restrict__ P, int L, const float* __restrict__ S0, const float* __restrict__ lbp,
                                                   const float* __restrict__ gn, float* MIX, float* Sout) {
    __shared__ float qt[128], fs[128], red[4][128], r2[2];
    const int b = blockIdx.x >> 2, h = blockIdx.x & 3, tid = threadIdx.x, dv = tid & 127, kq = tid >> 7;
    float S[32];
#pragma unroll
    for (int i = 0; i < 32; ++i) S[i] = S0 ? S0[((size_t)(b * 4 + h) * 128 + kq * 32 + i) * 128 + dv] : 0.f;
    float lb = 0.f;
    if (tid < 128) { const float p0 = lbp[h * 128 + tid], p1 = lbp[512 + h * 128 + tid]; lb = 1.f / (1.f + expf(p1 - p0)); }
    for (int t = 0; t < L; ++t) {
        const size_t r = (size_t)b * L + t; const float* pr = P + r * DIN;
        if (tid < 128) { qt[tid] = silu_f(pr[768 + h * 128 + tid]); fs[tid] = lb + (1.f - lb) * sigm_f(pr[1280 + h * 128 + tid]); }
        __syncthreads();
        const float v = pr[1792 + h * 128 + dv];
        float part = 0.f;
#pragma unroll
        for (int i = 0; i < 32; ++i) { const float f = fs[kq * 32 + i]; S[i] = f * S[i] + (1.f - f) * v; part = fmaf(qt[kq * 32 + i], S[i], part); }
        red[kq][dv] = part;
        __syncthreads();
        float o = 0.f, sq = 0.f;
        if (tid < 128) { o = red[0][tid] + red[1][tid] + red[2][tid] + red[3][tid]; sq = o * o;
#pragma unroll
            for (int off = 32; off > 0; off >>= 1) sq += __shfl_xor(sq, off);
            if ((tid & 63) == 0) r2[tid >> 6] = sq; }
        __syncthreads();
        if (tid < 128) { const float rs = 1.f / sqrtf((r2[0] + r2[1]) * (1.f / 128.f) + 1e-6f);
            MIX[r * D + 512 + h * 128 + tid] = o * rs * gn[h * 128 + tid] * silu_f(pr[2304 + h * 128 + tid]); }
        __syncthreads();
    }
#pragma unroll
    for (int i = 0; i < 32; ++i) Sout[((size_t)(b * 4 + h) * 128 + kq * 32 + i) * 128 + dv] = S[i];
}

template <bool SAMPLE>
__global__ void __launch_bounds__(256) cache_out(const float* __restrict__ P, const float* __restrict__ ck, const float* __restrict__ cv, float* Kout, float* Vout, int nb) {
    const int i = blockIdx.x * 256 + threadIdx.x;
    if (i >= nb * 128 * 128) return;
    const int c = i & 127, w = (i >> 7) & 127, b = i >> 14;
    float k, v;
    if (SAMPLE) { if (w < 120) { k = ck[(size_t)(b * 128 + w + 8) * 128 + c]; v = cv[(size_t)(b * 128 + w + 8) * 128 + c]; }
                  else { const float* pr = P + (size_t)(b * 8 + w - 120) * DIN; k = pr[512 + c]; v = pr[640 + c]; } }
    else { const float* pr = P + (size_t)(b * SEQ + 1920 + w) * DIN; k = pr[512 + c]; v = pr[640 + c]; }
    Kout[i] = k; Vout[i] = v;
}

struct Weights { const float *ln1g, *ln1b, *w13a, *w2a, *win, *lbp, *sink, *ang, *hng, *wout, *ln2g, *ln2b, *w13b, *w2b, *ln3g, *ln3b; };

static void run_group(hipStream_t st, const float* x, int M, bool sample, int nb, const float* S0, const float* ck, const float* cv, const Weights& W,
                      float* Y, float* PROJ, float* MIX, float* HCH, int CH, float* Sout, float* Kout, float* Vout,
                      float* snapH, float* snapX1, float* snapX2, float* snapH2) {
    for (int m0 = 0; m0 < M; m0 += CH) {
        const int mc = (M - m0 < CH) ? (M - m0) : CH;
        hipLaunchKernelGGL(sgemm<1>, dim3(DFF / 64, mc / 64), dim3(256), 0, st, x + (size_t)m0 * D, D, W.w13a, 2 * DFF, HCH, DFF, mc, DFF, D, nullptr, 0, 0.f, 0.f, DFF);
        if (snapH) (void)hipMemcpyAsync(snapH + (size_t)m0 * DFF, HCH, (size_t)mc * DFF * 4, hipMemcpyDeviceToDevice, st);
        hipLaunchKernelGGL(sgemm<2>, dim3(D / 64, mc / 64), dim3(256), 0, st, HCH, DFF, W.w2a, D, Y + (size_t)m0 * D, D, mc, D, DFF, x + (size_t)m0 * D, D, ALPHA, 0.5f, 0);
    }
    hipLaunchKernelGGL(layernorm_rows, dim3(M), dim3(256), 0, st, Y, Y, W.ln1g, W.ln1b);
    if (snapX1) (void)hipMemcpyAsync(snapX1, Y, (size_t)M * D * 4, hipMemcpyDeviceToDevice, st);
    hipLaunchKernelGGL(sgemm<0>, dim3(DIN / 64, M / 64), dim3(256), 0, st, Y, D, W.win, DIN, PROJ, DIN, M, DIN, D, nullptr, 0, 0.f, 0.f, 0);
    if (sample) hipLaunchKernelGGL(attn_naive<true>, dim3(M), dim3(256), 0, st, PROJ, ck, cv, W.sink, W.ang, MIX);
    else        hipLaunchKernelGGL(attn_naive<false>, dim3(M), dim3(256), 0, st, PROJ, ck, cv, W.sink, W.ang, MIX);
    hipLaunchKernelGGL(hgrn_naive, dim3(nb * 4), dim3(512), 0, st, PROJ, sample ? 8 : SEQ, S0, W.lbp, W.hng, MIX, Sout);
    if (sample) hipLaunchKernelGGL(cache_out<true>, dim3(nb * 64), dim3(256), 0, st, PROJ, ck, cv, Kout, Vout, nb);
    else        hipLaunchKernelGGL(cache_out<false>, dim3(nb * 64), dim3(256), 0, st, PROJ, ck, cv, Kout, Vout, nb);
    hipLaunchKernelGGL(sgemm<2>, dim3(D / 64, M / 64), dim3(256), 0, st, MIX, D, W.wout, D, Y, D, M, D, D, Y, D, ALPHA, 1.0f, 0);
    hipLaunchKernelGGL(layernorm_rows, dim3(M), dim3(256), 0, st, Y, Y, W.ln2g, W.ln2b);
    if (snapX2) (void)hipMemcpyAsync(snapX2, Y, (size_t)M * D * 4, hipMemcpyDeviceToDevice, st);
    for (int m0 = 0; m0 < M; m0 += CH) {
        const int mc = (M - m0 < CH) ? (M - m0) : CH;
        hipLaunchKernelGGL(sgemm<1>, dim3(DFF / 64, mc / 64), dim3(256), 0, st, Y + (size_t)m0 * D, D, W.w13b, 2 * DFF, HCH, DFF, mc, DFF, D, nullptr, 0, 0.f, 0.f, DFF);
        if (snapH2) (void)hipMemcpyAsync(snapH2 + (size_t)m0 * DFF, HCH, (size_t)mc * DFF * 4, hipMemcpyDeviceToDevice, st);
        hipLaunchKernelGGL(sgemm<2>, dim3(D / 64, mc / 64), dim3(256), 0, st, HCH, DFF, W.w2b, D, Y + (size_t)m0 * D, D, mc, D, DFF, Y + (size_t)m0 * D, D, ALPHA, 0.5f, 0);
    }
    hipLaunchKernelGGL(layernorm_rows, dim3(M), dim3(256), 0, st, Y, Y, W.ln3g, W.ln3b);
}
}
extern "C" void kernel_launch(void* const* d_in, const int* in_sizes, int n_in,
                              void* d_out, int out_size, void* d_ws, size_t ws_size,
                              hipStream_t stream) {
    const float* x_prompt = (const float*)d_in[0];
    const float* x_sample = (const float*)d_in[1];
    const float* state0 = (const float*)d_in[2];
    const float* ck = (const float*)d_in[3];
    const float* cv = (const float*)d_in[4];
    nv::Weights W;
    W.ln1g = (const float*)d_in[5]; W.ln1b = (const float*)d_in[6]; W.w13a = (const float*)d_in[7]; W.w2a = (const float*)d_in[8];
    W.win = (const float*)d_in[9]; W.lbp = (const float*)d_in[10]; W.sink = (const float*)d_in[11]; W.ang = (const float*)d_in[12];
    W.hng = (const float*)d_in[13]; W.wout = (const float*)d_in[14]; W.ln2g = (const float*)d_in[15]; W.ln2b = (const float*)d_in[16];
    W.w13b = (const float*)d_in[17]; W.w2b = (const float*)d_in[18]; W.ln3g = (const float*)d_in[19]; W.ln3b = (const float*)d_in[20];
    float* out = (float*)d_out;
    constexpr size_t OY = 0, OYS = 33554432, OSP = 34603008, OKP = 35651584, OVP = 35913728, OSS = 36175872, OKS = 44564480, OVS = 46661632;
    float* PROJ = (float*)d_ws;
    float* MIX = PROJ + (size_t)32768 * 2816;
    float* HCH = PROJ;
    nv::run_group(stream, x_prompt, 32768, false, 16, nullptr, nullptr, nullptr, W, out + OY, PROJ, MIX, HCH, 4096, out + OSP, out + OKP, out + OVP, nullptr, nullptr, nullptr, nullptr);
    nv::run_group(stream, x_sample, 1024, true, 128, state0, ck, cv, W, out + OYS, PROJ, MIX, HCH, 1024, out + OSS, out + OKS, out + OVS, nullptr, nullptr, nullptr, nullptr);
}
```

```cpp
#include <hip/hip_runtime.h>
#include <cstdio>
#include <cstdint>
#include <cmath>
namespace pg8 {
#define PG8_LAS __attribute__((address_space(3)))
typedef unsigned short bf16_t;
typedef short bf16x8 __attribute__((ext_vector_type(8)));
typedef float f32x4 __attribute__((ext_vector_type(4)));
typedef unsigned u32x4 __attribute__((ext_vector_type(4)));
constexpr int BM = 256, BK = 64, HALF = 128, HTB = HALF * BK * 2  , STAGE_BYTES = 8 * HTB, NXCD = 8, WGM = 8;

__host__ __device__ __forceinline__ int lds_byte(int r, int c) { const int st = (r >> 4) * 2 + (c >> 5), rr = r & 15, cc = c & 31, ob = rr * 64 + cc * 2; return st * 1024 + (ob ^ (((ob >> 9) & 1) << 5)); }
__host__ __device__ __forceinline__ void stage_rc(int b, int& R, int& C) { const int st = b / 1024, sb = b % 1024, swz = sb ^ (((sb >> 9) & 1) << 5); R = (st >> 1) * 16 + swz / 64; C = (st & 1) * 32 + (swz % 64) / 2; }
__host__ __device__ __forceinline__ int perm32(int rho) { const int n = rho >> 4, i = rho & 15; return 8 * (i >> 2) + 4 * n + (i & 3); }

struct Unit { int pm, pn; };
struct Gemm { const bf16_t* A; const bf16_t* Bt; int M, N, K; };

struct StaticOrder {
    int nM, nN, nwg, G, c;
    __host__ __device__ void init(int M, int N, int G_, int c_) { nM = M / BM; nN = N / BM; nwg = nM * nN; G = G_; c = c_; }
    __host__ __device__ bool next(int i, Unit& u) const {
        const long L = (long)i * G + c; if (L >= nwg) return false;
        int wgid = (int)L; { const int q = nwg / NXCD, r = nwg % NXCD, xcd = wgid % NXCD, off = wgid / NXCD; wgid = (xcd < r ? xcd * (q + 1) : r * (q + 1) + (xcd - r) * q) + off; }
        const int nig = WGM * nN, gid = wgid / nig, fm = gid * WGM, gsz = (nM - fm) < WGM ? (nM - fm) : WGM;
        u.pm = fm + ((wgid % nig) % gsz); u.pn = (wgid % nig) / gsz; return true;
    }
    __device__ __forceinline__ void a_ready(const Unit&) const {}
    __device__ __forceinline__ void done(const Unit&) const {}
};

__device__ __forceinline__ unsigned cvt_pk_bf16(float lo, float hi) { unsigned r; asm volatile("v_cvt_pk_bf16_f32 %0, %1, %2" : "=v"(r) : "v"(lo), "v"(hi)); return r; }
typedef _Float16 f16x2_t __attribute__((ext_vector_type(2)));
__device__ __forceinline__ unsigned cvt_pk_f16(float lo, float hi) { f16x2_t h; h.x = (_Float16)lo; h.y = (_Float16)hi; return __builtin_bit_cast(unsigned, h); }
__device__ __forceinline__ float sigm_fast(float x) { return __builtin_amdgcn_rcpf(1.f + __expf(-x)); }
__device__ __forceinline__ float silu_fast(float x) { return x * sigm_fast(x); }

struct EpiSwiGLU {
    static constexpr bool PERM = true, AFTER_DRAIN = false;
    bf16_t* O; int ldc;
    __device__ __forceinline__ void operator()(const f32x4 (&acc)[2][2][4][2], const Unit& u, int wr, int wc, int fr, int fq) const {
        const int row0 = u.pm * BM + wr * 64 + fr, col0 = u.pn * HALF + wc * 32 + 8 * fq;
#pragma unroll
        for (int ai = 0; ai < 2; ++ai)
#pragma unroll
            for (int m = 0; m < 4; ++m) { bf16_t* rowp = O + (size_t)(row0 + ai * HALF + m * 16) * ldc + col0;
                const f32x4 g0 = acc[ai][0][m][0], g1 = acc[ai][0][m][1], u0 = acc[ai][1][m][0], u1 = acc[ai][1][m][1];
                u32x4 w;
                w.x = cvt_pk_bf16(silu_fast(g0[0]) * u0[0], silu_fast(g0[1]) * u0[1]); w.y = cvt_pk_bf16(silu_fast(g0[2]) * u0[2], silu_fast(g0[3]) * u0[3]);
                w.z = cvt_pk_bf16(silu_fast(g1[0]) * u1[0], silu_fast(g1[1]) * u1[1]); w.w = cvt_pk_bf16(silu_fast(g1[2]) * u1[2], silu_fast(g1[3]) * u1[3]);
                *(u32x4*)rowp = w; }
    }
};
struct EpiProj {
    static constexpr bool PERM = true, AFTER_DRAIN = false;
    bf16_t* O; int ldc; const float* lb;
    __device__ __forceinline__ void operator()(const f32x4 (&acc)[2][2][4][2], const Unit& u, int wr, int wc, int fr, int fq) const {
        const int pn = u.pn, row0 = u.pm * BM + wr * 64 + fr, col0 = pn * BM + wc * 32 + 8 * fq;
        const int mode = (pn == 3 || pn == 4 || pn == 9 || pn == 10) ? 1 : ((pn == 5 || pn == 6) ? 2 : 0);
        f32x4 lbv[2][2];
#pragma unroll
        for (int bj = 0; bj < 2; ++bj)
#pragma unroll
            for (int n = 0; n < 2; ++n) lbv[bj][n] = (mode == 2) ? *(const f32x4*)(lb + (col0 + bj * HALF + 4 * n - 1280)) : (f32x4){0.f, 0.f, 0.f, 0.f};
#pragma unroll
        for (int ai = 0; ai < 2; ++ai)
#pragma unroll
            for (int m = 0; m < 4; ++m) { bf16_t* rowp = O + (size_t)(row0 + ai * HALF + m * 16) * ldc + col0;
#pragma unroll
                for (int bj = 0; bj < 2; ++bj) { f32x4 v0 = acc[ai][bj][m][0], v1 = acc[ai][bj][m][1]; u32x4 w;
                    if (mode == 1) {
#pragma unroll
                        for (int i = 0; i < 4; ++i) { v0[i] = silu_fast(v0[i]); v1[i] = silu_fast(v1[i]); } }
                    if (mode == 2) {
#pragma unroll
                        for (int i = 0; i < 4; ++i) { const float l0 = lbv[bj][0][i], l1 = lbv[bj][1][i];
                            v0[i] = __logf(l0 + (1.f - l0) * sigm_fast(v0[i])); v1[i] = __logf(l1 + (1.f - l1) * sigm_fast(v1[i])); }
                        w.x = cvt_pk_f16(v0[0], v0[1]); w.y = cvt_pk_f16(v0[2], v0[3]); w.z = cvt_pk_f16(v1[0], v1[1]); w.w = cvt_pk_f16(v1[2], v1[3]);
                    } else { w.x = cvt_pk_bf16(v0[0], v0[1]); w.y = cvt_pk_bf16(v0[2], v0[3]); w.z = cvt_pk_bf16(v1[0], v1[1]); w.w = cvt_pk_bf16(v1[2], v1[3]); }
                    *(u32x4*)(rowp + bj * HALF) = w; } }
    }
};
template <int KIND> struct EpiRes {
    static constexpr bool PERM = false, AFTER_DRAIN = false;
    float* out; const float* xp; const float* xs; const bf16_t* rb; float alpha, scale;
    __device__ __forceinline__ void operator()(const f32x4 (&acc)[2][2][4][2], const Unit& u, int wr, int wc, int fr, int fq) const {
        typedef unsigned u32x2v __attribute__((ext_vector_type(2)));
        const int row0 = u.pm * BM + wr * 64 + fr, col0 = u.pn * BM + wc * 32 + 4 * fq;
#pragma unroll
        for (int ai = 0; ai < 2; ++ai)
#pragma unroll
            for (int m = 0; m < 4; ++m) { const int r = row0 + ai * HALF + m * 16;
                const float* xr = (KIND == 0) ? ((r < 32768) ? xp + (size_t)r * 1024 : xs + (size_t)(r - 32768) * 1024) : nullptr;
#pragma unroll
                for (int bj = 0; bj < 2; ++bj)
#pragma unroll
                    for (int n = 0; n < 2; ++n) { const int c = col0 + bj * HALF + n * 16; f32x4 rs;
                        if (KIND == 0) rs = *(const f32x4*)(xr + c);
                        else { const u32x2v q = *(const u32x2v*)(rb + (size_t)r * 1024 + c);
                            rs[0] = __uint_as_float(q.x << 16); rs[1] = __uint_as_float(q.x & 0xffff0000u); rs[2] = __uint_as_float(q.y << 16); rs[3] = __uint_as_float(q.y & 0xffff0000u); }
                        *(f32x4*)(out + (size_t)r * 1024 + c) = rs * alpha + acc[ai][bj][m][n] * scale; }
                asm volatile("" ::: "memory"); }
    }
};

template <class Epi, class Sched, bool ALIGN_EPI = false, bool SP2 = false>
__device__ __forceinline__ void gemm_phase(PG8_LAS unsigned char* lds, const Gemm g, const Sched& S, const Epi& E) {
    const int tid = threadIdx.x, wid = __builtin_amdgcn_readfirstlane(tid >> 6), lane = tid & 63, wr = wid >> 2, wc = wid & 3, fr = lane & 15, fq = lane >> 4;
    const int K = g.K, nt = K / BK;
    unsigned voffA[2], voffB[2];
#pragma unroll
    for (int i = 0; i < 2; ++i) { int R, C; stage_rc(tid * 16 + i * 8192, R, C); const int Rb = Epi::PERM ? ((R & ~31) + perm32(R & 31)) : R;
        voffA[i] = (unsigned)(R * K + C) * 2u; voffB[i] = (unsigned)(Rb * K + C) * 2u; }
    const size_t kstep = (size_t)(BK * 2);
    const size_t hstep = (size_t)HALF * K * 2;
    const size_t tstep = 2 * hstep;
    const unsigned ldsw = (unsigned)wid * 1024u;
    const int aoff = lds_byte(wr * 64 + fr, fq * 8), boff = lds_byte(wc * 32 + fr, fq * 8);
#define PG8_SA(b, h) (((b) * 2 + (h)) * HTB)
#define PG8_SB(b, h) ((4 + (b) * 2 + (h)) * HTB)
#define PG8_STAGE(bufoff, gbase, voff) do { _Pragma("unroll") for (int _i = 0; _i < 2; ++_i) \
        __builtin_amdgcn_global_load_lds((const unsigned*)((const char*)(gbase) + (voff)[_i]), (PG8_LAS unsigned*)(lds + (bufoff) + ldsw + _i * 8192), 16, 0, 0); } while (0)
#define PG8_LDA(dst, b, h) do { _Pragma("unroll") for (int m = 0; m < 4; ++m) _Pragma("unroll") for (int k = 0; k < 2; ++k) dst[m][k] = *(const PG8_LAS bf16x8*)(lds + PG8_SA(b, h) + aoff + m * 2048 + k * 1024); } while (0)
#define PG8_LDB(dst, b, h) do { _Pragma("unroll") for (int n = 0; n < 2; ++n) _Pragma("unroll") for (int k = 0; k < 2; ++k) dst[n][k] = *(const PG8_LAS bf16x8*)(lds + PG8_SB(b, h) + boff + n * 2048 + k * 1024); } while (0)
#define PG8_MMA(ai, bj, At, Bt) do { __builtin_amdgcn_s_setprio(1); _Pragma("unroll") for (int m = 0; m < 4; ++m) _Pragma("unroll") for (int n = 0; n < 2; ++n) _Pragma("unroll") for (int k = 0; k < 2; ++k) \
        acc[ai][bj][m][n] = __builtin_amdgcn_mfma_f32_16x16x32_bf16(Bt[n][k], At[m][k], acc[ai][bj][m][n], 0, 0, 0); __builtin_amdgcn_s_setprio(0); } while (0)
#define PG8_WAIT_V(n) asm volatile("s_waitcnt vmcnt(" #n ")" ::: "memory")
#define PG8_WAIT_L(n) asm volatile("s_waitcnt lgkmcnt(" #n ")" ::: "memory")
#define PG8_BAR __builtin_amdgcn_s_barrier()
#define PG8_SCHED __builtin_amdgcn_sched_barrier(0)
    Unit cur, nxt; int ui = 0;
    if (!S.next(0, cur)) return;
    f32x4 acc[2][2][4][2];
#pragma unroll
    for (int a = 0; a < 2; ++a)
#pragma unroll
        for (int b = 0; b < 2; ++b)
#pragma unroll
            for (int m = 0; m < 4; ++m)
#pragma unroll
                for (int n = 0; n < 2; ++n) acc[a][b][m][n] = (f32x4){0.f, 0.f, 0.f, 0.f};
    bf16x8 At[4][2], B0[2][2], B1[2][2];
    const char* cA = (const char*)g.A + (size_t)cur.pm * tstep; const char* cB = (const char*)g.Bt + (size_t)cur.pn * tstep;
    S.a_ready(cur);
    if constexpr (SP2) {
        PG8_STAGE(PG8_SB(0, 0), cB, voffB); PG8_STAGE(PG8_SB(0, 1), cB + hstep, voffB); PG8_STAGE(PG8_SA(0, 0), cA, voffA); PG8_STAGE(PG8_SA(0, 1), cA + hstep, voffA);
        if (wr == 1) PG8_BAR;
        PG8_WAIT_V(2); PG8_BAR;
        PG8_STAGE(PG8_SB(1, 0), cB + kstep, voffB); PG8_STAGE(PG8_SA(1, 0), cA + kstep, voffA); PG8_STAGE(PG8_SB(1, 1), cB + hstep + kstep, voffB);
        PG8_WAIT_V(6); PG8_BAR;
    } else {
        PG8_STAGE(PG8_SB(0, 0), cB, voffB); PG8_STAGE(PG8_SA(0, 0), cA, voffA); PG8_STAGE(PG8_SB(0, 1), cB + hstep, voffB); PG8_STAGE(PG8_SA(0, 1), cA + hstep, voffA);
        if (wr == 1) PG8_BAR;
        PG8_WAIT_V(4); PG8_BAR;
        PG8_STAGE(PG8_SB(1, 0), cB + kstep, voffB); PG8_STAGE(PG8_SA(1, 0), cA + kstep, voffA); PG8_STAGE(PG8_SB(1, 1), cB + hstep + kstep, voffB);
        PG8_WAIT_V(6); PG8_BAR;
    }
    for (;;) {
        const bool has_next = S.next(ui + 1, nxt);
        const char* nA = has_next ? (const char*)g.A + (size_t)nxt.pm * tstep : cA; const char* nB = has_next ? (const char*)g.Bt + (size_t)nxt.pn * tstep : cB;
        for (int t = 0; t < nt; t += 2) {
            const bool last = (t == nt - 2);
            const char* a1 = cA + (size_t)(t + 1) * kstep;
            const char* a2 = last ? nA : cA + (size_t)(t + 2) * kstep; const char* b2 = last ? nB : cB + (size_t)(t + 2) * kstep;
            const char* a3 = a2 + kstep; const char* b3 = b2 + kstep;
            if (last && has_next) S.a_ready(nxt);
            if constexpr (SP2) {
            PG8_LDB(B0, 0, 0); PG8_LDB(B1, 0, 1); PG8_SCHED; PG8_LDA(At, 0, 0); PG8_STAGE(PG8_SA(1, 1), a1 + hstep, voffA);
            PG8_WAIT_V(8); PG8_WAIT_L(0); PG8_BAR; PG8_MMA(0, 0, At, B0); PG8_MMA(0, 1, At, B1); PG8_BAR; PG8_SCHED;
            PG8_LDA(At, 0, 1); PG8_STAGE(PG8_SB(0, 0), b2, voffB); PG8_STAGE(PG8_SB(0, 1), b2 + hstep, voffB); PG8_STAGE(PG8_SA(0, 0), a2, voffA);
            PG8_WAIT_V(8); PG8_WAIT_L(0); PG8_BAR; PG8_MMA(1, 0, At, B0); PG8_MMA(1, 1, At, B1); PG8_BAR; PG8_SCHED;
            PG8_LDB(B0, 1, 0); PG8_LDB(B1, 1, 1); PG8_SCHED; PG8_LDA(At, 1, 0); PG8_STAGE(PG8_SA(0, 1), a2 + hstep, voffA);
            PG8_WAIT_V(8); PG8_WAIT_L(0); PG8_BAR; PG8_MMA(0, 0, At, B0); PG8_MMA(0, 1, At, B1); PG8_BAR; PG8_SCHED;
            PG8_LDA(At, 1, 1); PG8_STAGE(PG8_SB(1, 0), b3, voffB); PG8_STAGE(PG8_SB(1, 1), b3 + hstep, voffB); PG8_STAGE(PG8_SA(1, 0), a3, voffA);
            PG8_WAIT_V(8); PG8_WAIT_L(0); PG8_BAR; PG8_MMA(1, 0, At, B0); PG8_MMA(1, 1, At, B1); PG8_BAR; PG8_SCHED;
            } else {
            PG8_LDB(B0, 0, 0); PG8_SCHED; PG8_LDA(At, 0, 0); PG8_STAGE(PG8_SA(1, 1), a1 + hstep, voffA);
            PG8_WAIT_L(8); PG8_BAR; PG8_WAIT_L(0); PG8_MMA(0, 0, At, B0); PG8_BAR; PG8_SCHED;
            PG8_LDB(B1, 0, 1); PG8_STAGE(PG8_SB(0, 0), b2, voffB);
            PG8_BAR; PG8_WAIT_L(0); PG8_MMA(0, 1, At, B1); PG8_BAR;
            PG8_LDA(At, 0, 1); PG8_STAGE(PG8_SA(0, 0), a2, voffA);
            PG8_BAR; PG8_WAIT_L(0); PG8_MMA(1, 0, At, B0); PG8_BAR; PG8_SCHED;
            PG8_STAGE(PG8_SB(0, 1), b2 + hstep, voffB);
            PG8_WAIT_V(6); PG8_BAR; PG8_MMA(1, 1, At, B1); PG8_BAR;
            PG8_LDB(B0, 1, 0); PG8_SCHED; PG8_LDA(At, 1, 0); PG8_STAGE(PG8_SA(0, 1), a2 + hstep, voffA);
            PG8_WAIT_L(8); PG8_BAR; PG8_WAIT_L(0); PG8_MMA(0, 0, At, B0); PG8_BAR; PG8_SCHED;
            PG8_LDB(B1, 1, 1); PG8_STAGE(PG8_SB(1, 0), b3, voffB);
            PG8_BAR; PG8_WAIT_L(0); PG8_MMA(0, 1, At, B1); PG8_BAR;
            PG8_LDA(At, 1, 1); PG8_STAGE(PG8_SA(1, 0), a3, voffA);
            PG8_BAR; PG8_WAIT_L(0); PG8_MMA(1, 0, At, B0); PG8_BAR; PG8_SCHED;
            PG8_STAGE(PG8_SB(1, 1), b3 + hstep, voffB);
            PG8_WAIT_V(6); PG8_BAR; PG8_MMA(1, 1, At, B1); PG8_BAR;
            }
        }
        if constexpr (ALIGN_EPI) { if (wr == 0) PG8_BAR; }
        if constexpr (!Epi::AFTER_DRAIN) { E(acc, cur, wr, wc, fr, fq); S.done(cur); }
        if (!has_next) break;
#pragma unroll
        for (int a = 0; a < 2; ++a)
#pragma unroll
            for (int b = 0; b < 2; ++b)
#pragma unroll
                for (int m = 0; m < 4; ++m)
#pragma unroll
                    for (int n = 0; n < 2; ++n) acc[a][b][m][n] = (f32x4){0.f, 0.f, 0.f, 0.f};
        cur = nxt; cA = nA; cB = nB; ++ui;
        if constexpr (ALIGN_EPI) { if (wr == 1) PG8_BAR; }
    }
    PG8_WAIT_V(0);
    if constexpr (!ALIGN_EPI) { if (wr == 0) PG8_BAR; }
    PG8_BAR;
    if constexpr (Epi::AFTER_DRAIN) { E.fused(acc, cur, wr, wc, fr, fq, lds, wid, lane); S.done(cur); }
#undef PG8_SA
#undef PG8_SB
#undef PG8_STAGE
#undef PG8_LDA
#undef PG8_LDB
#undef PG8_MMA
#undef PG8_WAIT_V
#undef PG8_WAIT_L
#undef PG8_BAR
#undef PG8_SCHED
}
}
#define GAS __attribute__((address_space(1)))
#define LAS __attribute__((address_space(3)))
typedef unsigned short bf16;
typedef unsigned v4u __attribute__((ext_vector_type(4)));
typedef float f32x4 __attribute__((ext_vector_type(4)));
typedef short bf16x8 __attribute__((ext_vector_type(8)));
typedef GAS unsigned gu32;
typedef GAS unsigned long long gu64;
#define RLX_AGENT __ATOMIC_RELAXED, __HIP_MEMORY_SCOPE_AGENT
#define LDS_WAIT() asm volatile("s_waitcnt lgkmcnt(0)" ::: "memory")
#define VM_WAIT() asm volatile("s_waitcnt vmcnt(0)" ::: "memory")
__device__ __forceinline__ unsigned long long rt() { return __builtin_amdgcn_s_memrealtime(); }
__device__ __forceinline__ unsigned f2bf(float f) { unsigned u = __builtin_bit_cast(unsigned, f); return (u + 0x7fffu + ((u >> 16) & 1u)) >> 16; }
__device__ __forceinline__ unsigned pk2(float lo, float hi) { return f2bf(lo) | (f2bf(hi) << 16); }

#define XB_TMO      128
#define XB_XCNT(j)  (256  + 64 * (j))
#define XB_XSUB(j)  (1280 + 64 * (j))
#define XB_XGEN(j)  (2304 + 64 * (j))
#define XB_TOP      3328
#define XB_TOPGEN   3392
#define XCD_BAR_WORDS 3456
#define XB_SPIN_CAP (1u << 18)

__device__ __forceinline__ unsigned xb_ld(unsigned* p)              { return __hip_atomic_load(p, __ATOMIC_RELAXED, __HIP_MEMORY_SCOPE_AGENT); }
__device__ __forceinline__ unsigned xb_add(unsigned* p, unsigned v) { return __hip_atomic_fetch_add(p, v, __ATOMIC_RELAXED, __HIP_MEMORY_SCOPE_AGENT); }
__device__ __forceinline__ unsigned xb_xcc_id() { return (unsigned)__builtin_amdgcn_s_getreg((3 << 11) | 20) & 0xFu; }
#define XB_SPIN(cond, bar) do { unsigned _sp = 0; while (cond) { __builtin_amdgcn_s_sleep(1); \
    if ((++_sp & 255u) == 0u) { if (xb_ld(&(bar)[XB_TMO])) break; if (_sp > XB_SPIN_CAP) { atomicAdd(&(bar)[XB_TMO], 1u); break; } } } } while (0)

struct XcdBarrier {
    unsigned* bar; unsigned x;
    volatile LAS unsigned* st;
};

__device__ __forceinline__ XcdBarrier xcd_barrier_post(unsigned* bar, volatile LAS unsigned* st) {
    XcdBarrier b; b.bar = bar; b.x = xb_xcc_id(); b.st = st;
    if (threadIdx.x == 0) (void)xb_add(&bar[XB_XCNT(b.x)], 1u);
    return b;
}
__device__ __forceinline__ void xcd_barrier_complete(unsigned* bar, unsigned x, unsigned& nloc, unsigned& nx) {
    const unsigned G = gridDim.x * gridDim.y * gridDim.z;
    unsigned sum, cnt, mine, sp = 0u;
    for (;;) {
        sum = 0u; cnt = 0u; mine = 0u;
#pragma unroll
        for (unsigned j = 0; j < 16; ++j) { const unsigned c = xb_ld(&bar[XB_XCNT(j)]); sum += c; cnt += (c > 0u) ? 1u : 0u; mine = (j == x) ? c : mine; }
        if (sum == G) break;
        __builtin_amdgcn_s_sleep(1);
        if ((++sp & 255u) == 0u) { if (xb_ld(&bar[XB_TMO])) break; if (sp > XB_SPIN_CAP) { atomicAdd(&bar[XB_TMO], 1u); break; } }
    }
    nloc = mine > 0u ? mine : 1u; nx = cnt > 0u ? cnt : 1u;
}

__device__ __forceinline__ void xcd_barrier(const XcdBarrier& b) {
    asm volatile("s_waitcnt vmcnt(0)" ::: "memory");
    __syncthreads();
    if (threadIdx.x == 0) {
        unsigned* bar = b.bar;
        __builtin_amdgcn_s_waitcnt(0);
        unsigned nloc = b.st[0], nx = b.st[1];
        if (nloc == 0u) { xcd_barrier_complete(bar, b.x, nloc, nx); b.st[0] = nloc; b.st[1] = nx; }
        const unsigned old = xb_add(&bar[XB_XSUB(b.x)], 1u);
        const unsigned gen = old / nloc;
        if (old + 1u == (gen + 1u) * nloc) {
            __builtin_amdgcn_fence(__ATOMIC_RELEASE, "agent");
            asm volatile("s_waitcnt vmcnt(0)" ::: "memory");
            const unsigned og = xb_add(&bar[XB_TOP], 1u);
            const unsigned tg = og / nx;
            if (og + 1u == (tg + 1u) * nx) xb_add(&bar[XB_TOPGEN], 1u);
            else XB_SPIN(xb_ld(&bar[XB_TOPGEN]) == tg, bar);
            __builtin_amdgcn_fence(__ATOMIC_ACQUIRE, "agent");
            xb_add(&bar[XB_XGEN(b.x)], 1u);
            asm volatile("s_waitcnt vmcnt(0)" ::: "memory");
        } else {
            XB_SPIN(xb_ld(&bar[XB_XGEN(b.x)]) == gen, bar);
            __builtin_amdgcn_fence(__ATOMIC_ACQUIRE, "agent");
            asm volatile("s_waitcnt vmcnt(0)" ::: "memory");
        }
    }
    __syncthreads();
}

constexpr int NWAVES = 8;
constexpr int MTOT = 33792, MP = 32768, DM = 1024, DFF = 2816, DIN = 2816, SEQ = 2048;
constexpr float ALPHA = 1.189207115002721f, LOG2E = 1.4426950408889634f;
constexpr size_t MiB = 1u << 20;
constexpr size_t WS_CTL = 0, CTL_ZERO_BYTES = 1 * MiB, WS_LB = 1 * MiB;
constexpr size_t WS_W13A = 2 * MiB, WS_W2A = 13 * MiB, WS_WIN = 19 * MiB, WS_WOUT = 25 * MiB, WS_W13B = 27 * MiB, WS_W2B = 38 * MiB;
constexpr size_t WS_XB = 44 * MiB;
constexpr size_t WS_HP = 110 * MiB;
constexpr size_t WS_X1 = 292 * MiB;
constexpr size_t WS_ST = 358 * MiB;
constexpr size_t WS_END = 424 * MiB;
constexpr int CW_TMO = 0, CW_CODE = 1, CW_BAR = 4096;
constexpr size_t OY = 0, OYS = 33554432, OSP = 34603008, OKP = 35651584, OVP = 35913728, OSS = 36175872, OKS = 44564480, OVS = 46661632;
constexpr int RING_OFF = 0, RING_BYTES = 131072, LDSCTL_OFF = RING_BYTES, MISC_OFF = LDSCTL_OFF + 320, XS_OFF = RING_BYTES + 1024, LDS_BYTES = 147456;

typedef unsigned u32x2 __attribute__((ext_vector_type(2)));
typedef short s16x4 __attribute__((ext_vector_type(4)));
typedef float f32x2 __attribute__((ext_vector_type(2)));
typedef _Float16 f16x2 __attribute__((ext_vector_type(2)));

struct Frame {
    LAS unsigned char* lds; volatile LAS unsigned* MISC; gu32* ctl;
    int tid, lane, wave, vcu, G;
};
__device__ __forceinline__ float bflo(unsigned w) { return __uint_as_float(w << 16); }
__device__ __forceinline__ float bfhi(unsigned w) { return __uint_as_float(w & 0xffff0000u); }
__device__ __forceinline__ unsigned pkbf(float lo, float hi) { return pg8::cvt_pk_bf16(lo, hi); }
__device__ __forceinline__ s16x4 ds_tr16(LAS const unsigned char* p) { return __builtin_bit_cast(s16x4, __builtin_amdgcn_ds_read_tr16_b64_v4i16((LAS s16x4*)p)); }
__device__ __forceinline__ bf16x8 cat4(s16x4 a, s16x4 b) { return (bf16x8){a[0], a[1], a[2], a[3], b[0], b[1], b[2], b[3]}; }
__device__ __forceinline__ bf16x8 pack8(f32x4 a, f32x4 b) { v4u w; w.x = pkbf(a[0], a[1]); w.y = pkbf(a[2], a[3]); w.z = pkbf(b[0], b[1]); w.w = pkbf(b[2], b[3]); return __builtin_bit_cast(bf16x8, w); }
__device__ __forceinline__ f32x4 mfma16(bf16x8 a, bf16x8 b, f32x4 c) { return __builtin_amdgcn_mfma_f32_16x16x32_bf16(a, b, c, 0, 0, 0); }
__device__ __forceinline__ int off256(int row, int k) { return row * 256 + ((((k >> 3) ^ (row & 15))) << 4) + (k & 7) * 2; }

__device__ __forceinline__ float wave_sum(float v) {
#pragma unroll
    for (int o = 1; o < 64; o <<= 1) v += __shfl_xor(v, o);
    return v;
}
__device__ __forceinline__ void p0_transpose_item(const float* W, int K, int ldw, int Ndst, bf16* WT, int mode, LAS float* scr, int item, int lane) {
    const int nblk = Ndst / 32, kb = item / nblk, nb = item % nblk, k0 = 64 * kb, n0 = 32 * nb;
    const int c0 = (mode == 1) ? (((n0 >> 7) & 1) * 2816 + (n0 >> 8) * 128 + (n0 & 127)) : n0;
#pragma unroll 8
    for (int i = 0; i < 32; ++i) { const int kk = 2 * i + (lane >> 5); scr[kk * 33 + (lane & 31)] = W[(size_t)(k0 + kk) * ldw + c0 + (lane & 31)]; }
    LDS_WAIT(); asm volatile("" ::: "memory");
    const int c = lane & 7;
#pragma unroll
    for (int j = 0; j < 4; ++j) { const int n = (lane >> 3) + 8 * j; const LAS float* s = scr + (8 * c) * 33 + n;
        v4u o; o.x = pk2(s[0 * 33], s[1 * 33]); o.y = pk2(s[2 * 33], s[3 * 33]); o.z = pk2(s[4 * 33], s[5 * 33]); o.w = pk2(s[6 * 33], s[7 * 33]);
        *(GAS v4u*)(WT + (size_t)(n0 + n) * K + k0 + 8 * c) = o; }
    LDS_WAIT(); asm volatile("" ::: "memory");
}
struct Ptrs {
    const float *xp, *xs, *st0, *ck, *cv, *ln1g, *ln1b, *w13a, *w2a, *win, *lbp, *sink, *ang, *hng, *wout, *ln2g, *ln2b, *w13b, *w2b, *ln3g, *ln3b;
    float* out; float* LB;
    bf16 *W13A, *W2A, *WIN, *WOUT, *W13B, *W2B, *XB, *HP, *X1, *ST, *X2, *MIX;
};
__device__ __forceinline__ void p0_prologue(Frame& F, const Ptrs& P) {
    LAS float* scr = (LAS float*)(F.lds + RING_OFF + F.wave * 16384);
    const int gw = F.vcu * NWAVES + F.wave, NGW = F.G * NWAVES;
    constexpr int I13 = 16 * 176, I2 = 44 * 32, IIN = 16 * 88, IOUT = 16 * 32;
    constexpr int NITEMS = 2 * I13 + 2 * I2 + IIN + IOUT;
    for (int it = gw; it < NITEMS; it += NGW) {
        int r = it;
        if (r < I13) { p0_transpose_item(P.w13a, 1024, 5632, 5632, P.W13A, 1, scr, r, F.lane); continue; } r -= I13;
        if (r < I13) { p0_transpose_item(P.w13b, 1024, 5632, 5632, P.W13B, 1, scr, r, F.lane); continue; } r -= I13;
        if (r < I2) { p0_transpose_item(P.w2a, 2816, 1024, 1024, P.W2A, 0, scr, r, F.lane); continue; } r -= I2;
        if (r < I2) { p0_transpose_item(P.w2b, 2816, 1024, 1024, P.W2B, 0, scr, r, F.lane); continue; } r -= I2;
        if (r < IIN) { p0_transpose_item(P.win, 1024, 2816, 2816, P.WIN, 0, scr, r, F.lane); continue; } r -= IIN;
        p0_transpose_item(P.wout, 1024, 1024, 1024, P.WOUT, 0, scr, r, F.lane);
    }
    for (int m = gw; m < MTOT; m += NGW) {
        const float* xr = (m < MP) ? P.xp + (size_t)m * DM : P.xs + (size_t)(m - MP) * DM;
        const GAS f32x4* xv = (const GAS f32x4*)xr + F.lane; GAS u32x2* o8 = (GAS u32x2*)(P.XB + (size_t)m * DM) + F.lane;
#pragma unroll
        for (int j = 0; j < 4; ++j) { const f32x4 v = xv[64 * j]; u32x2 w; w.x = pkbf(v[0], v[1]); w.y = pkbf(v[2], v[3]); o8[64 * j] = w; }
    }
    if (F.vcu == 0) { const float p0 = P.lbp[F.tid], p1 = P.lbp[512 + F.tid]; P.LB[F.tid] = 1.f / (1.f + __expf(p1 - p0)); }
}
template <bool F32OUT> __device__ __forceinline__ void ln_pass(Frame& F, const float* V, bf16* Xo, float* Yo, const float* gam, const float* bet) {
    const int gw = F.vcu * NWAVES + F.wave, NGW = F.G * NWAVES;
    f32x4 gv[4], bv[4];
#pragma unroll
    for (int j = 0; j < 4; ++j) { gv[j] = *((const f32x4*)gam + F.lane + 64 * j); bv[j] = *((const f32x4*)bet + F.lane + 64 * j); }
    for (int m = gw; m < MTOT; m += NGW) {
        const GAS f32x4* xr = (const GAS f32x4*)(V + (size_t)m * DM) + F.lane;
        f32x4 v[4]; float s = 0.f;
#pragma unroll
        for (int j = 0; j < 4; ++j) { v[j] = xr[64 * j]; s += (v[j][0] + v[j][1]) + (v[j][2] + v[j][3]); }
        const float mean = wave_sum(s) * (1.f / DM); float s2 = 0.f;
#pragma unroll
        for (int j = 0; j < 4; ++j) { v[j] = v[j] - mean; s2 += (v[j][0] * v[j][0] + v[j][1] * v[j][1]) + (v[j][2] * v[j][2] + v[j][3] * v[j][3]); }
        const float rstd = 1.f / sqrtf(wave_sum(s2) * (1.f / DM) + 1e-5f);
#pragma unroll
        for (int j = 0; j < 4; ++j) { const f32x4 o = v[j] * rstd * gv[j] + bv[j];
            if (F32OUT) *((GAS f32x4*)(Yo + (size_t)m * DM) + F.lane + 64 * j) = o;
            else { u32x2 w; w.x = pkbf(o[0], o[1]); w.y = pkbf(o[2], o[3]); *((GAS u32x2*)(Xo + (size_t)m * DM) + F.lane + 64 * j) = w; } }
    }
}
template <bool SAMPLE>
__device__ __forceinline__ void attn_unit(Frame& F, const Ptrs& P, int b, int n) {
    LAS unsigned char* L = F.lds;
    const bf16* PROJ = P.HP;
    const int tid = F.tid, lane = F.lane, w = F.wave, fr = lane & 15, g = lane >> 4;
    if (!SAMPLE) {
        const long rowb = (long)b * SEQ + 128 * (n - 1);
#pragma unroll 4
        for (int i = 0; i < 16; ++i) { const int id = tid + 512 * i, key = id >> 5, c32 = id & 31;
            v4u v = (v4u){0u, 0u, 0u, 0u};
            if (n > 0 || key >= 128) v = *(const v4u*)(PROJ + (size_t)(rowb + key) * DIN + 512 + c32 * 8);
            *(LAS v4u*)(L + (c32 >> 3) * 32768 + key * 128 + (((c32 & 7) ^ (key & 7)) << 4)) = v; }
    } else {
#pragma unroll 3
        for (int i = 0; i < 9; ++i) { const int id = tid + 512 * i, key = id >> 5, c32 = id & 31, tile = c32 >> 3, kh = tile & 1, c8 = c32 & 7;
            v4u v = (v4u){0u, 0u, 0u, 0u};
            if (key < 128) { const float* src = ((tile < 2) ? P.ck : P.cv) + ((size_t)(b * 128 + key) * 2 + kh) * 64 + c8 * 8;
                const f32x4 a = *(const f32x4*)src, c = *(const f32x4*)(src + 4); v.x = pkbf(a[0], a[1]); v.y = pkbf(a[2], a[3]); v.z = pkbf(c[0], c[1]); v.w = pkbf(c[2], c[3]); }
            else if (key < 136) v = *(const v4u*)(PROJ + (size_t)(MP + 8 * b + key - 128) * DIN + 512 + c32 * 8);
            *(LAS v4u*)(L + tile * 32768 + key * 128 + ((c8 ^ (key & 7)) << 4)) = v; }
    }
    if (!SAMPLE) {
        if (n == 15) {
#pragma unroll 2
            for (int i = 0; i < 8; ++i) { const int id = tid + 512 * i, wr = id >> 5, c32 = id & 31;
                const v4u v = *(const v4u*)(PROJ + (size_t)(b * SEQ + 1920 + wr) * DIN + 512 + c32 * 8);
                float* dst = ((c32 < 16) ? P.out + OKP : P.out + OVP) + (size_t)(b * 128 + wr) * 128 + (c32 & 15) * 8;
                *(f32x4*)dst = (f32x4){bflo(v.x), bfhi(v.x), bflo(v.y), bfhi(v.y)}; *(f32x4*)(dst + 4) = (f32x4){bflo(v.z), bfhi(v.z), bflo(v.w), bfhi(v.w)}; }
        }
    } else {
#pragma unroll 3
        for (int i = 0; i < 15; ++i) { const int id = tid + 512 * i, which = id / 3840, rem = id % 3840, wr = rem >> 5, c4 = rem & 31;
            const f32x4 v = *(const f32x4*)((which ? P.cv : P.ck) + (size_t)(b * 128 + wr + 8) * 128 + c4 * 4);
            *(f32x4*)((which ? P.out + OVS : P.out + OKS) + (size_t)(b * 128 + wr) * 128 + c4 * 4) = v; }
        if (tid < 256) { const int wr = tid >> 5, c32 = tid & 31;
            const v4u v = *(const v4u*)(PROJ + (size_t)(MP + 8 * b + wr) * DIN + 512 + c32 * 8);
            float* dst = ((c32 < 16) ? P.out + OKS : P.out + OVS) + (size_t)(b * 128 + 120 + wr) * 128 + (c32 & 15) * 8;
            *(f32x4*)dst = (f32x4){bflo(v.x), bfhi(v.x), bflo(v.y), bfhi(v.y)}; *(f32x4*)(dst + 4) = (f32x4){bflo(v.z), bfhi(v.z), bflo(v.w), bfhi(v.w)}; }
    }
    __syncthreads();
    const int h = w, kh = h >> 2;
    const float slope2 = exp2f(-(float)(h + 1)) * LOG2E, sink2 = P.sink[h] * LOG2E, sc2 = 0.125f * LOG2E;
    LAS const unsigned char* Kt = L + kh * 32768; LAS const unsigned char* Vt = L + 65536 + kh * 32768;
    LAS float* SCR = (LAS float*)(L + XS_OFF);
    constexpr int NPASS = SAMPLE ? 1 : 2, QTP = SAMPLE ? 1 : 4;
    for (int pass = 0; pass < NPASS; ++pass) {
        f32x4 o[QTP][4]; float ssq[QTP];
#pragma unroll
        for (int q = 0; q < QTP; ++q) {
            const int qt = pass * 4 + q;
            long qrow; if (!SAMPLE) qrow = (long)b * SEQ + 128 * n + 16 * qt + fr; else qrow = MP + 8 * b + ((fr < 8) ? fr : 0);
            bf16x8 qf[2];
#pragma unroll
            for (int kk = 0; kk < 2; ++kk) qf[kk] = *(const bf16x8*)(PROJ + (size_t)qrow * DIN + h * 64 + 32 * kk + 8 * g);
            f32x4 s[9];
#pragma unroll
            for (int i = 0; i < 9; ++i) { const int key = 16 * (qt + i) + fr; LAS const unsigned char* kp = Kt + key * 128;
                const bf16x8 k0 = *(LAS const bf16x8*)(kp + ((g ^ (key & 7)) << 4)), k1 = *(LAS const bf16x8*)(kp + (((g + 4) ^ (key & 7)) << 4));
                f32x4 a = (f32x4){0.f, 0.f, 0.f, 0.f}; a = mfma16(k0, qf[0], a); a = mfma16(k1, qf[1], a); s[i] = a; }
            float mx = -INFINITY;
#pragma unroll
            for (int i = 0; i < 9; ++i)
#pragma unroll
                for (int r = 0; r < 4; ++r) { const int dist = 128 + fr - 16 * i - 4 * g - r;
                    const bool valid = (dist >= 0) && (dist < 128) && (SAMPLE || n > 0 || (16 * (qt + i) + 4 * g + r) >= 128);
                    const float x = valid ? (s[i][r] * sc2 - slope2 * (float)dist) : -INFINITY; s[i][r] = x; mx = fmaxf(mx, x); }
            mx = fmaxf(mx, __shfl_xor(mx, 16)); mx = fmaxf(mx, __shfl_xor(mx, 32)); mx = fmaxf(mx, sink2);
            float sum = 0.f;
#pragma unroll
            for (int i = 0; i < 9; ++i)
#pragma unroll
                for (int r = 0; r < 4; ++r) { const float p = __builtin_amdgcn_exp2f(s[i][r] - mx); s[i][r] = p; sum += p; }
            sum += __shfl_xor(sum, 16); sum += __shfl_xor(sum, 32); sum += __builtin_amdgcn_exp2f(sink2 - mx);
            const float inv = 1.f / sum;
            bf16x8 pf[5];
#pragma unroll
            for (int ks = 0; ks < 4; ++ks) pf[ks] = pack8(s[2 * ks], s[2 * ks + 1]);
            pf[4] = pack8(s[8], (f32x4){0.f, 0.f, 0.f, 0.f});
            float sq = 0.f;
#pragma unroll
            for (int dt = 0; dt < 4; ++dt) { f32x4 acc = (f32x4){0.f, 0.f, 0.f, 0.f};
#pragma unroll
                for (int ks = 0; ks < 5; ++ks) { const int row1 = 16 * (qt + 2 * ks) + 4 * g + (fr >> 2), row2 = (ks < 4) ? row1 + 16 : row1, chunk = 2 * dt + ((fr & 3) >> 1), sub = (fr & 1) * 8;
                    const s16x4 a1 = ds_tr16(Vt + row1 * 128 + ((chunk ^ (row1 & 7)) << 4) + sub), a2 = ds_tr16(Vt + row2 * 128 + ((chunk ^ (row2 & 7)) << 4) + sub);
                    acc = mfma16(cat4(a1, a2), pf[ks], acc); }
                acc = acc * inv; o[q][dt] = acc; sq += (acc[0] * acc[0] + acc[1] * acc[1]) + (acc[2] * acc[2] + acc[3] * acc[3]); }
            sq += __shfl_xor(sq, 16); sq += __shfl_xor(sq, 32); ssq[q] = sq;
            if (g == 0) SCR[h * 64 + q * 16 + fr] = sq;
        }
        __syncthreads();
#pragma unroll
        for (int q = 0; q < QTP; ++q) {
            const int qt = pass * 4 + q; float tot = 0.f;
#pragma unroll
            for (int hh = 0; hh < 8; ++hh) tot += SCR[hh * 64 + q * 16 + fr];
            const float rms = __builtin_amdgcn_rsqf(tot * (1.f / 512.f) + 1e-6f);
            long qrow; bool qv = true; if (!SAMPLE) qrow = (long)b * SEQ + 128 * n + 16 * qt + fr; else { qv = fr < 8; qrow = MP + 8 * b + (qv ? fr : 0); }
#pragma unroll
            for (int dt = 0; dt < 4; ++dt) { const f32x4 gn = *(const f32x4*)(P.ang + h * 64 + 16 * dt + 4 * g); const f32x4 v = o[q][dt] * rms * gn;
                u32x2 wv; wv.x = pkbf(v[0], v[1]); wv.y = pkbf(v[2], v[3]);
                if (qv) *(u32x2*)(P.MIX + (size_t)qrow * DM + h * 64 + 16 * dt + 4 * g) = wv; }
        }
        __syncthreads();
    }
}
__device__ __forceinline__ void hgrn_state_chain(Frame& F, const Ptrs& P, int b, int h, int dvs) {
    LAS unsigned char* L = F.lds;
    const bf16* PROJ = P.HP;
    const int tid = F.tid, lane = F.lane, w = F.wave, fr = lane & 15, g = lane >> 4, kp = tid & 63, seg = w;
    const size_t rowb = (size_t)b * SEQ;
    LAS float* TOT = (LAS float*)(L + 20480); LAS float* DEC = (LAS float*)(L + 24576);
    unsigned lfw[8]; v4u vv = (v4u){0u, 0u, 0u, 0u};
#define HS_LOAD(c) do { const bf16* p_ = PROJ + (rowb + 64 * (c) + 8 * seg) * DIN + 1280 + 128 * h + 2 * kp; \
        _Pragma("unroll") for (int i_ = 0; i_ < 8; ++i_) lfw[i_] = *(const unsigned*)(p_ + (size_t)i_ * DIN); \
        if (tid < 256) vv = *(const v4u*)(PROJ + (rowb + 64 * (c) + (tid >> 2)) * DIN + 1792 + 128 * h + 32 * dvs + 8 * (tid & 3)); } while (0)
    f32x4 acc[2]; acc[0] = (f32x4){0.f, 0.f, 0.f, 0.f}; acc[1] = (f32x4){0.f, 0.f, 0.f, 0.f};
    HS_LOAD(0);
    for (int c = 0; c < 32; ++c) {
        float lf0[8], lf1[8], bl0[8], bl1[8]; float t0 = 0.f, t1 = 0.f;
#pragma unroll
        for (int i = 0; i < 8; ++i) { const f16x2 hh = __builtin_bit_cast(f16x2, lfw[i]); lf0[i] = (float)hh.x; lf1[i] = (float)hh.y; t0 += lf0[i]; t1 += lf1[i]; bl0[i] = t0; bl1[i] = t1; }
        *(LAS f32x2*)(TOT + seg * 128 + 2 * kp) = (f32x2){t0, t1};
        if (tid < 256) *(LAS v4u*)(L + 16384 + (tid >> 2) * 64 + (tid & 3) * 16) = vv;
        __syncthreads();
        float pre0 = 0.f, pre1 = 0.f, tot0 = 0.f, tot1 = 0.f;
#pragma unroll
        for (int s2 = 0; s2 < 8; ++s2) { const f32x2 tv = *(LAS f32x2*)(TOT + s2 * 128 + 2 * kp); tot0 += tv.x; tot1 += tv.y; if (s2 < seg) { pre0 += tv.x; pre1 += tv.y; } }
#pragma unroll
        for (int i = 0; i < 8; ++i) { const float k0 = (1.f - __expf(lf0[i])) * __expf(tot0 - (pre0 + bl0[i])), k1 = (1.f - __expf(lf1[i])) * __expf(tot1 - (pre1 + bl1[i]));
            *(LAS unsigned*)(L + off256(8 * seg + i, 2 * kp)) = pkbf(k0, k1); }
        if (seg == 0) *(LAS f32x2*)(DEC + 2 * kp) = (f32x2){__expf(tot0), __expf(tot1)};
        if (c + 1 < 32) HS_LOAD(c + 1);
        __syncthreads();
#pragma unroll
        for (int nt = 0; nt < 2; ++nt) { u32x2 sv; sv.x = pkbf(acc[nt][0], acc[nt][1]); sv.y = pkbf(acc[nt][2], acc[nt][3]);
            *(u32x2*)(P.ST + ((((size_t)b * 32 + c) * 4 + h) * 128 + (32 * dvs + 16 * nt + fr)) * 128 + 16 * w + 4 * g) = sv; }
        const f32x4 dv4 = *(LAS f32x4*)(DEC + 16 * w + 4 * g);
        acc[0] = acc[0] * dv4; acc[1] = acc[1] * dv4;
#pragma unroll
        for (int ks = 0; ks < 2; ++ks) { const int row1 = 32 * ks + 4 * g + (fr >> 2), row2 = row1 + 16, ck = 16 * w + 4 * (fr & 3);
            const bf16x8 A = cat4(ds_tr16(L + off256(row1, ck)), ds_tr16(L + off256(row2, ck)));
#pragma unroll
            for (int nt = 0; nt < 2; ++nt) { const int cv2 = (16 * nt + 4 * (fr & 3)) * 2;
                const bf16x8 Bv = cat4(ds_tr16(L + 16384 + row1 * 64 + cv2), ds_tr16(L + 16384 + row2 * 64 + cv2));
                acc[nt] = mfma16(A, Bv, acc[nt]); } }
        __syncthreads();
    }
#undef HS_LOAD
#pragma unroll
    for (int nt = 0; nt < 2; ++nt)
#pragma unroll
        for (int r = 0; r < 4; ++r) P.out[OSP + (((size_t)b * 4 + h) * 128 + 16 * w + 4 * g + r) * 128 + 32 * dvs + 16 * nt + fr] = acc[nt][r];
}
__device__ __forceinline__ void hgrn_out_unit(Frame& F, const Ptrs& P, int b, int c, int h) {
    LAS unsigned char* L = F.lds;
    const bf16* PROJ = P.HP;
    const int tid = F.tid, lane = F.lane, w = F.wave, fr = lane & 15, g = lane >> 4, kp = tid & 63, seg = w;
    const size_t row0 = (size_t)b * SEQ + 64 * c;
    LAS float* TOT = (LAS float*)(L + 65536); LAS float* SSQ = (LAS float*)(L + 69632);
    unsigned qw[8], lfw[8];
    { const bf16* p_ = PROJ + (row0 + 8 * seg) * DIN + 128 * h + 2 * kp;
#pragma unroll
      for (int i = 0; i < 8; ++i) { qw[i] = *(const unsigned*)(p_ + (size_t)i * DIN + 768); lfw[i] = *(const unsigned*)(p_ + (size_t)i * DIN + 1280); } }
#pragma unroll
    for (int j = 0; j < 2; ++j) { const int id = tid + 512 * j, row = id >> 4, ch = id & 15;
        const v4u v = *(const v4u*)(PROJ + (row0 + row) * DIN + 1792 + 128 * h + 8 * ch);
        *(LAS v4u*)(L + 49152 + row * 256 + ((ch ^ (row & 15)) << 4)) = v; }
    float lf0[8], lf1[8], bl0[8], bl1[8]; float t0 = 0.f, t1 = 0.f;
#pragma unroll
    for (int i = 0; i < 8; ++i) { const f16x2 hh = __builtin_bit_cast(f16x2, lfw[i]); lf0[i] = (float)hh.x; lf1[i] = (float)hh.y; t0 += lf0[i]; t1 += lf1[i]; bl0[i] = t0; bl1[i] = t1; }
    *(LAS f32x2*)(TOT + seg * 128 + 2 * kp) = (f32x2){t0, t1};
    __syncthreads();
    float pre0 = 0.f, pre1 = 0.f, tot0 = 0.f, tot1 = 0.f;
#pragma unroll
    for (int s2 = 0; s2 < 8; ++s2) { const f32x2 tv = *(LAS f32x2*)(TOT + s2 * 128 + 2 * kp); tot0 += tv.x; tot1 += tv.y; if (s2 < seg) { pre0 += tv.x; pre1 += tv.y; } }
#pragma unroll
    for (int i = 0; i < 8; ++i) { const float b0 = pre0 + bl0[i], b1 = pre1 + bl1[i], q0 = bflo(qw[i]), q1 = bfhi(qw[i]);
        const int o_ = off256(8 * seg + i, 2 * kp);
        *(LAS unsigned*)(L + o_) = pkbf(q0 * __expf(b0), q1 * __expf(b1));
        *(LAS unsigned*)(L + 16384 + o_) = pkbf(q0 * __expf(b0 - tot0), q1 * __expf(b1 - tot1));
        *(LAS unsigned*)(L + 32768 + o_) = pkbf((1.f - __expf(lf0[i])) * __expf(tot0 - b0), (1.f - __expf(lf1[i])) * __expf(tot1 - b1)); }
    __syncthreads();
    const int tt = w & 3, dh = w >> 2, t = 16 * tt + fr;
    f32x4 at[4];
#pragma unroll
    for (int st = 0; st < 4; ++st) { f32x4 a = (f32x4){0.f, 0.f, 0.f, 0.f};
#pragma unroll
        for (int kk = 0; kk < 4; ++kk) { const bf16x8 Kf = *(LAS const bf16x8*)(L + 32768 + off256(16 * st + fr, 8 * g + 32 * kk)), Qf = *(LAS const bf16x8*)(L + 16384 + off256(t, 8 * g + 32 * kk));
            a = mfma16(Kf, Qf, a); }
#pragma unroll
        for (int r = 0; r < 4; ++r) if (16 * st + 4 * g + r > t) a[r] = 0.f;
        at[st] = a; }
    bf16x8 bfr[2]; bfr[0] = pack8(at[0], at[1]); bfr[1] = pack8(at[2], at[3]);
    bf16x8 qh[4];
#pragma unroll
    for (int kk = 0; kk < 4; ++kk) qh[kk] = *(LAS const bf16x8*)(L + off256(t, 8 * g + 32 * kk));
    const bf16* STu = P.ST + ((((size_t)b * 32 + c) * 4 + h) * 128) * 128;
    f32x4 oo[4]; float sq = 0.f;
#pragma unroll
    for (int dvt = 0; dvt < 4; ++dvt) { const int dvb = 16 * (4 * dh + dvt); f32x4 o = (f32x4){0.f, 0.f, 0.f, 0.f};
#pragma unroll
        for (int ks = 0; ks < 2; ++ks) { const int row1 = 32 * ks + 4 * g + (fr >> 2), cc = dvb + 4 * (fr & 3);
            o = mfma16(cat4(ds_tr16(L + 49152 + off256(row1, cc)), ds_tr16(L + 49152 + off256(row1 + 16, cc))), bfr[ks], o); }
#pragma unroll
        for (int kk = 0; kk < 4; ++kk) { const bf16x8 Sf = *(const bf16x8*)(STu + (size_t)(dvb + fr) * 128 + 8 * g + 32 * kk); o = mfma16(Sf, qh[kk], o); }
        oo[dvt] = o; sq += (o[0] * o[0] + o[1] * o[1]) + (o[2] * o[2] + o[3] * o[3]); }
    sq += __shfl_xor(sq, 16); sq += __shfl_xor(sq, 32);
    if (g == 0) SSQ[dh * 64 + t] = sq;
    __syncthreads();
    const float rms = __builtin_amdgcn_rsqf((SSQ[t] + SSQ[64 + t]) * (1.f / 128.f) + 1e-6f);
#pragma unroll
    for (int dvt = 0; dvt < 4; ++dvt) { const int dv = 16 * (4 * dh + dvt) + 4 * g;
        const u32x2 gt = *(const u32x2*)(PROJ + (row0 + t) * DIN + 2304 + 128 * h + dv); const f32x4 gn = *(const f32x4*)(P.hng + 128 * h + dv);
        const f32x4 o = oo[dvt] * rms * gn; u32x2 wv; wv.x = pkbf(o[0] * bflo(gt.x), o[1] * bfhi(gt.x)); wv.y = pkbf(o[2] * bflo(gt.y), o[3] * bfhi(gt.y));
        *(u32x2*)(P.MIX + (row0 + t) * DM + 512 + 128 * h + dv) = wv; }
    __syncthreads();
}
__device__ __forceinline__ void hgrn_sample_unit(Frame& F, const Ptrs& P, int b, int h) {
    LAS unsigned char* L = F.lds;
    const unsigned short* PR = (const unsigned short*)P.HP;
    const int tid = F.tid, lane = F.lane, w = F.wave, dv = tid & 127, kq = tid >> 7;
    const size_t r0 = (size_t)MP + 8 * b;
    LAS float* REC = (LAS float*)L; LAS float* AM = (LAS float*)(L + 10240); LAS float* OP = (LAS float*)(L + 10496); LAS float* RSQ = (LAS float*)(L + 26880);
    if (tid < 128) { const int k = tid; float bb = 0.f, lf[8], q[8], bs[8];
#pragma unroll
        for (int t = 0; t < 8; ++t) { lf[t] = (float)__builtin_bit_cast(_Float16, PR[(r0 + t) * DIN + 1280 + 128 * h + k]); q[t] = __uint_as_float((unsigned)PR[(r0 + t) * DIN + 768 + 128 * h + k] << 16); bb += lf[t]; bs[t] = bb; }
#pragma unroll
        for (int t = 0; t < 8; ++t) { REC[k * 20 + t] = q[t] * __expf(bs[t]); REC[k * 20 + 8 + t] = (1.f - __expf(lf[t])) * __expf(bb - bs[t]); }
        REC[k * 20 + 16] = __expf(bb); }
    float v[8];
#pragma unroll
    for (int s = 0; s < 8; ++s) v[s] = __uint_as_float((unsigned)PR[(r0 + s) * DIN + 1792 + 128 * h + dv] << 16);
    __syncthreads();
    { const int p = tid >> 3, t = p >> 3, s = p & 7, part = tid & 7; float a = 0.f;
#pragma unroll 4
      for (int kk = 0; kk < 16; ++kk) { const int k = part * 16 + kk; a += REC[k * 20 + t] * REC[k * 20 + 8 + s] / REC[k * 20 + 16]; }
      a += __shfl_xor(a, 1); a += __shfl_xor(a, 2); a += __shfl_xor(a, 4);
      if (part == 0) AM[t * 8 + s] = (s <= t) ? a : 0.f; }
    float o[8];
#pragma unroll
    for (int t = 0; t < 8; ++t) o[t] = 0.f;
    const float* S0 = P.st0 + ((size_t)b * 4 + h) * 16384; float* S1 = P.out + OSS + ((size_t)b * 4 + h) * 16384;
#pragma unroll 4
    for (int kk = 0; kk < 32; ++kk) { const int k = kq * 32 + kk; const float s0 = S0[k * 128 + dv];
        const f32x4 r0v = *(LAS f32x4*)(REC + k * 20), r1v = *(LAS f32x4*)(REC + k * 20 + 4), r2v = *(LAS f32x4*)(REC + k * 20 + 8), r3v = *(LAS f32x4*)(REC + k * 20 + 12); const float dec = REC[k * 20 + 16];
        o[0] += r0v[0] * s0; o[1] += r0v[1] * s0; o[2] += r0v[2] * s0; o[3] += r0v[3] * s0; o[4] += r1v[0] * s0; o[5] += r1v[1] * s0; o[6] += r1v[2] * s0; o[7] += r1v[3] * s0;
        float sn = dec * s0;
        sn += r2v[0] * v[0]; sn += r2v[1] * v[1]; sn += r2v[2] * v[2]; sn += r2v[3] * v[3]; sn += r3v[0] * v[4]; sn += r3v[1] * v[5]; sn += r3v[2] * v[6]; sn += r3v[3] * v[7];
        S1[k * 128 + dv] = sn; }
#pragma unroll
    for (int t = 0; t < 8; ++t) OP[(kq * 8 + t) * 128 + dv] = o[t];
    __syncthreads();
    float oe[2];
#pragma unroll
    for (int e = 0; e < 2; ++e) { const int t = 2 * kq + e; float x = OP[t * 128 + dv] + OP[(8 + t) * 128 + dv] + OP[(16 + t) * 128 + dv] + OP[(24 + t) * 128 + dv];
#pragma unroll
        for (int s = 0; s < 8; ++s) x += AM[t * 8 + s] * v[s];
        oe[e] = x; const float sq = wave_sum(x * x); if (lane == 0) RSQ[t * 2 + (w & 1)] = sq; }
    __syncthreads();
#pragma unroll
    for (int e = 0; e < 2; ++e) { const int t = 2 * kq + e; const float rms = __builtin_amdgcn_rsqf((RSQ[t * 2] + RSQ[t * 2 + 1]) * (1.f / 128.f) + 1e-6f);
        const float gate = __uint_as_float((unsigned)PR[(r0 + t) * DIN + 2304 + 128 * h + dv] << 16);
        const float y = oe[e] * rms * P.hng[128 * h + dv] * gate;
        ((unsigned short*)P.MIX)[(r0 + t) * DM + 512 + 128 * h + dv] = (unsigned short)(pkbf(y, 0.f) & 0xffffu); }
    __syncthreads();
}
#ifndef PG8_SP2
#define PG8_SP2 true
#endif
#ifndef PG8_ALIGN
#define PG8_ALIGN true
#endif
constexpr int NPH = 12;
struct Args { const float* in[21]; float* out; unsigned char* ws; int ph_lo, ph_hi, li, pad; };
__global__ void __launch_bounds__(NWAVES * 64, 2) mk_fwd(Args args) {
    extern __shared__ __attribute__((aligned(16))) unsigned char lds[];
    Frame F;
    F.lds = (LAS unsigned char*)lds;
    F.MISC = (volatile LAS unsigned*)(F.lds + MISC_OFF);
    F.tid = threadIdx.x; F.lane = F.tid & 63; F.wave = __builtin_amdgcn_readfirstlane(F.tid >> 6);
    F.G = gridDim.x; { const int bx = blockIdx.x; F.vcu = (F.G % 8 == 0) ? (bx % 8) * (F.G / 8) + bx / 8 : bx; }
    unsigned char* ws = args.ws;
    F.ctl = (gu32*)(ws + WS_CTL);
    Ptrs P;
    P.xp = args.in[0]; P.xs = args.in[1]; P.st0 = args.in[2]; P.ck = args.in[3]; P.cv = args.in[4]; P.ln1g = args.in[5]; P.ln1b = args.in[6]; P.w13a = args.in[7]; P.w2a = args.in[8];
    P.win = args.in[9]; P.lbp = args.in[10]; P.sink = args.in[11]; P.ang = args.in[12]; P.hng = args.in[13]; P.wout = args.in[14]; P.ln2g = args.in[15]; P.ln2b = args.in[16];
    P.w13b = args.in[17]; P.w2b = args.in[18]; P.ln3g = args.in[19]; P.ln3b = args.in[20];
    P.out = args.out; P.LB = (float*)(ws + WS_LB);
    P.W13A = (bf16*)(ws + WS_W13A); P.W2A = (bf16*)(ws + WS_W2A); P.WIN = (bf16*)(ws + WS_WIN); P.WOUT = (bf16*)(ws + WS_WOUT); P.W13B = (bf16*)(ws + WS_W13B); P.W2B = (bf16*)(ws + WS_W2B);
    P.XB = (bf16*)(ws + WS_XB); P.HP = (bf16*)(ws + WS_HP); P.X1 = (bf16*)(ws + WS_X1); P.ST = (bf16*)(ws + WS_ST); P.X2 = (bf16*)(ws + WS_ST); P.MIX = (bf16*)(ws + WS_XB);
    for (int u = F.tid; u < (LDS_BYTES - LDSCTL_OFF) / 4; u += NWAVES * 64) ((LAS unsigned*)(F.lds + LDSCTL_OFF))[u] = 0u;
    __syncthreads();
    const int lo = args.ph_lo, hi = args.ph_hi;
    XcdBarrier bar; bar.bar = (unsigned*)(F.ctl + CW_BAR) + args.li * XCD_BAR_WORDS; bar.x = 0; bar.st = nullptr;
    if (hi - lo > 1) bar = xcd_barrier_post((unsigned*)(F.ctl + CW_BAR) + args.li * XCD_BAR_WORDS, F.MISC + 8);
#define IN(k) (lo <= (k) && (k) < hi)
#define SEAM(k) do { if (IN(k) && IN((k) + 1)) xcd_barrier(bar); } while (0)
    float* V = P.out;
    if (IN(0)) { p0_prologue(F, P); SEAM(0); }
    if (IN(1)) { pg8::Gemm g{P.XB, P.W13A, MTOT, 2 * DFF, DM}; pg8::StaticOrder S; S.init(MTOT, 2 * DFF, F.G, (int)blockIdx.x);
        pg8::EpiSwiGLU E{P.HP, DFF};
        pg8::gemm_phase<pg8::EpiSwiGLU, pg8::StaticOrder, PG8_ALIGN, PG8_SP2>(F.lds + RING_OFF, g, S, E); SEAM(1); }
    if (IN(2)) { pg8::Gemm g{P.HP, P.W2A, MTOT, DM, DFF}; pg8::StaticOrder S; S.init(MTOT, DM, F.G, (int)blockIdx.x);
        pg8::EpiRes<0> E{V, P.xp, P.xs, nullptr, ALPHA, 0.5f};
        pg8::gemm_phase<pg8::EpiRes<0>, pg8::StaticOrder, PG8_ALIGN, PG8_SP2>(F.lds + RING_OFF, g, S, E); SEAM(2); }
    if (IN(3)) { ln_pass<false>(F, V, P.X1, nullptr, P.ln1g, P.ln1b); SEAM(3); }
    if (IN(4)) { pg8::Gemm g{P.X1, P.WIN, MTOT, DIN, DM}; pg8::StaticOrder S; S.init(MTOT, DIN, F.G, (int)blockIdx.x);
        pg8::EpiProj E{P.HP, DIN, P.LB};
        pg8::gemm_phase<pg8::EpiProj, pg8::StaticOrder, PG8_ALIGN, PG8_SP2>(F.lds + RING_OFF, g, S, E); SEAM(4); }
    if (IN(5)) {
        for (int u = F.vcu; u < 256; u += F.G) hgrn_state_chain(F, P, u >> 4, (u >> 2) & 3, u & 3);
        for (int u = F.vcu; u < 256; u += F.G) attn_unit<false>(F, P, u >> 4, u & 15);
        for (int u = F.vcu; u < 128; u += F.G) attn_unit<true>(F, P, u, 0);
        for (int u = F.vcu; u < 512; u += F.G) hgrn_sample_unit(F, P, u >> 2, u & 3);
        SEAM(5); }
    if (IN(6)) { for (int u = F.vcu; u < 2048; u += F.G) hgrn_out_unit(F, P, u >> 7, (u >> 2) & 31, u & 3); SEAM(6); }
    if (IN(7)) { pg8::Gemm g{P.MIX, P.WOUT, MTOT, DM, DM}; pg8::StaticOrder S; S.init(MTOT, DM, F.G, (int)blockIdx.x);
        pg8::EpiRes<1> E{V, nullptr, nullptr, P.X1, ALPHA, 1.0f};
        pg8::gemm_phase<pg8::EpiRes<1>, pg8::StaticOrder, PG8_ALIGN, PG8_SP2>(F.lds + RING_OFF, g, S, E); SEAM(7); }
    if (IN(8)) { ln_pass<false>(F, V, P.X2, nullptr, P.ln2g, P.ln2b); SEAM(8); }
    if (IN(9)) { pg8::Gemm g{P.X2, P.W13B, MTOT, 2 * DFF, DM}; pg8::StaticOrder S; S.init(MTOT, 2 * DFF, F.G, (int)blockIdx.x);
        pg8::EpiSwiGLU E{P.HP, DFF};
        pg8::gemm_phase<pg8::EpiSwiGLU, pg8::StaticOrder, PG8_ALIGN, PG8_SP2>(F.lds + RING_OFF, g, S, E); SEAM(9); }
    if (IN(10)) { pg8::Gemm g{P.HP, P.W2B, MTOT, DM, DFF}; pg8::StaticOrder S; S.init(MTOT, DM, F.G, (int)blockIdx.x);
        pg8::EpiRes<1> E{V, nullptr, nullptr, P.X2, ALPHA, 0.5f};
        pg8::gemm_phase<pg8::EpiRes<1>, pg8::StaticOrder, PG8_ALIGN, PG8_SP2>(F.lds + RING_OFF, g, S, E); SEAM(10); }
    if (IN(11)) { ln_pass<true>(F, V, nullptr, V, P.ln3g, P.ln3b); }
#undef IN
#undef SEAM
}
static int mk_grid() {
    static int grid = 0;
    if (grid == 0) {
        int dev = 0, cus = 0;
        if (hipGetDevice(&dev) != hipSuccess || hipDeviceGetAttribute(&cus, hipDeviceAttributeMultiprocessorCount, dev) != hipSuccess) { fprintf(stderr, "kernel_launch: device query failed\n"); grid = -1; return grid; }
        if (hipFuncSetAttribute((const void*)mk_fwd, hipFuncAttributeMaxDynamicSharedMemorySize, LDS_BYTES) != hipSuccess) { fprintf(stderr, "kernel_launch: hipFuncSetAttribute failed\n"); grid = -1; return grid; }
        int per_cu = 0;
        if (hipOccupancyMaxActiveBlocksPerMultiprocessor(&per_cu, (const void*)mk_fwd, NWAVES * 64, LDS_BYTES) != hipSuccess || per_cu < 1) fprintf(stderr, "kernel_launch: occupancy query reports %d\n", per_cu);
        (void)hipGetLastError();
        grid = cus;
    }
    return grid;
}
static void mk_launch(void* const* d_in, void* d_out, void* d_ws, hipStream_t stream, int lo, int hi, int li) {
    const int grid = mk_grid(); if (grid < 0) return;
    Args a{};
    for (int i = 0; i < 21; ++i) a.in[i] = (const float*)d_in[i];
    a.out = (float*)d_out; a.ws = (unsigned char*)d_ws; a.ph_lo = lo; a.ph_hi = hi; a.li = li; a.pad = 0;
    hipLaunchKernelGGL(mk_fwd, dim3(grid), dim3(NWAVES * 64), LDS_BYTES, stream, a);
}
extern "C" void kernel_launch(void* const* d_in, const int* in_sizes, int n_in, void* d_out, int out_size, void* d_ws, size_t ws_size, hipStream_t stream) {
    if (ws_size < WS_END) { fprintf(stderr, "kernel_launch: workspace too small\n"); return; }
    (void)hipMemsetAsync((char*)d_ws + WS_CTL, 0, CTL_ZERO_BYTES, stream);
    mk_launch(d_in, d_out, d_ws, stream, 0, NPH, 0);
}
```

```cpp
#include <hip/hip_runtime.h>
#include <cstdio>
#include <cstdint>
#include <cmath>
namespace pg8 {
#define PG8_LAS __attribute__((address_space(3)))
typedef unsigned short bf16_t;
typedef short bf16x8 __attribute__((ext_vector_type(8)));
typedef float f32x4 __attribute__((ext_vector_type(4)));
typedef unsigned u32x4 __attribute__((ext_vector_type(4)));
constexpr int BM = 256, BK = 64, HALF = 128, HTB = HALF * BK * 2  , STAGE_BYTES = 8 * HTB, NXCD = 8, WGM = 8;

__host__ __device__ __forceinline__ int lds_byte(int r, int c) { const int st = (r >> 4) * 2 + (c >> 5), rr = r & 15, cc = c & 31, ob = rr * 64 + cc * 2; return st * 1024 + (ob ^ (((ob >> 9) & 1) << 5)); }
__host__ __device__ __forceinline__ void stage_rc(int b, int& R, int& C) { const int st = b / 1024, sb = b % 1024, swz = sb ^ (((sb >> 9) & 1) << 5); R = (st >> 1) * 16 + swz / 64; C = (st & 1) * 32 + (swz % 64) / 2; }
__host__ __device__ __forceinline__ int perm32(int rho) { const int n = rho >> 4, i = rho & 15; return 8 * (i >> 2) + 4 * n + (i & 3); }

struct Unit { int pm, pn; };
struct Gemm { const bf16_t* A; const bf16_t* Bt; int M, N, K; };

struct StaticOrder {
    int nM, nN, nwg, G, c;
    __host__ __device__ void init(int M, int N, int G_, int c_) { nM = M / BM; nN = N / BM; nwg = nM * nN; G = G_; c = c_; }
    __host__ __device__ bool next(int i, Unit& u) const {
        const long L = (long)i * G + c; if (L >= nwg) return false;
        int wgid = (int)L; { const int q = nwg / NXCD, r = nwg % NXCD, xcd = wgid % NXCD, off = wgid / NXCD; wgid = (xcd < r ? xcd * (q + 1) : r * (q + 1) + (xcd - r) * q) + off; }
        const int nig = WGM * nN, gid = wgid / nig, fm = gid * WGM, gsz = (nM - fm) < WGM ? (nM - fm) : WGM;
        u.pm = fm + ((wgid % nig) % gsz); u.pn = (wgid % nig) / gsz; return true;
    }
    __device__ __forceinline__ void a_ready(const Unit&) const {}
    __device__ __forceinline__ void done(const Unit&) const {}
};

__device__ __forceinline__ unsigned cvt_pk_bf16(float lo, float hi) { unsigned r; asm volatile("v_cvt_pk_bf16_f32 %0, %1, %2" : "=v"(r) : "v"(lo), "v"(hi)); return r; }
typedef _Float16 f16x2_t __attribute__((ext_vector_type(2)));
__device__ __forceinline__ unsigned cvt_pk_f16(float lo, float hi) { f16x2_t h; h.x = (_Float16)lo; h.y = (_Float16)hi; return __builtin_bit_cast(unsigned, h); }
__device__ __forceinline__ float sigm_fast(float x) { return __builtin_amdgcn_rcpf(1.f + __expf(-x)); }
__device__ __forceinline__ float silu_fast(float x) { return x * sigm_fast(x); }

struct EpiSwiGLU {
    static constexpr bool PERM = true, AFTER_DRAIN = false;
    bf16_t* O; int ldc;
    __device__ __forceinline__ void operator()(const f32x4 (&acc)[2][2][4][2], const Unit& u, int wr, int wc, int fr, int fq) const {
        const int row0 = u.pm * BM + wr * 64 + fr, col0 = u.pn * HALF + wc * 32 + 8 * fq;
#pragma unroll
        for (int ai = 0; ai < 2; ++ai)
#pragma unroll
            for (int m = 0; m < 4; ++m) { bf16_t* rowp = O + (size_t)(row0 + ai * HALF + m * 16) * ldc + col0;
                const f32x4 g0 = acc[ai][0][m][0], g1 = acc[ai][0][m][1], u0 = acc[ai][1][m][0], u1 = acc[ai][1][m][1];
                u32x4 w;
                w.x = cvt_pk_bf16(silu_fast(g0[0]) * u0[0], silu_fast(g0[1]) * u0[1]); w.y = cvt_pk_bf16(silu_fast(g0[2]) * u0[2], silu_fast(g0[3]) * u0[3]);
                w.z = cvt_pk_bf16(silu_fast(g1[0]) * u1[0], silu_fast(g1[1]) * u1[1]); w.w = cvt_pk_bf16(silu_fast(g1[2]) * u1[2], silu_fast(g1[3]) * u1[3]);
                *(u32x4*)rowp = w; }
    }
};
struct EpiProj {
    static constexpr bool PERM = true, AFTER_DRAIN = false;
    bf16_t* O; int ldc; const float* lb;
    __device__ __forceinline__ void operator()(const f32x4 (&acc)[2][2][4][2], const Unit& u, int wr, int wc, int fr, int fq) const {
        const int pn = u.pn, row0 = u.pm * BM + wr * 64 + fr, col0 = pn * BM + wc * 32 + 8 * fq;
        const int mode = (pn == 3 || pn == 4 || pn == 9 || pn == 10) ? 1 : ((pn == 5 || pn == 6) ? 2 : 0);
        f32x4 lbv[2][2];
#pragma unroll
        for (int bj = 0; bj < 2; ++bj)
#pragma unroll
            for (int n = 0; n < 2; ++n) lbv[bj][n] = (mode == 2) ? *(const f32x4*)(lb + (col0 + bj * HALF + 4 * n - 1280)) : (f32x4){0.f, 0.f, 0.f, 0.f};
#pragma unroll
        for (int ai = 0; ai < 2; ++ai)
#pragma unroll
            for (int m = 0; m < 4; ++m) { bf16_t* rowp = O + (size_t)(row0 + ai * HALF + m * 16) * ldc + col0;
#pragma unroll
                for (int bj = 0; bj < 2; ++bj) { f32x4 v0 = acc[ai][bj][m][0], v1 = acc[ai][bj][m][1]; u32x4 w;
                    if (mode == 1) {
#pragma unroll
                        for (int i = 0; i < 4; ++i) { v0[i] = silu_fast(v0[i]); v1[i] = silu_fast(v1[i]); } }
                    if (mode == 2) {
#pragma unroll
                        for (int i = 0; i < 4; ++i) { const float l0 = lbv[bj][0][i], l1 = lbv[bj][1][i];
                            v0[i] = __logf(l0 + (1.f - l0) * sigm_fast(v0[i])); v1[i] = __logf(l1 + (1.f - l1) * sigm_fast(v1[i])); }
                        w.x = cvt_pk_f16(v0[0], v0[1]); w.y = cvt_pk_f16(v0[2], v0[3]); w.z = cvt_pk_f16(v1[0], v1[1]); w.w = cvt_pk_f16(v1[2], v1[3]);
                    } else { w.x = cvt_pk_bf16(v0[0], v0[1]); w.y = cvt_pk_bf16(v0[2], v0[3]); w.z = cvt_pk_bf16(v1[0], v1[1]); w.w = cvt_pk_bf16(v1[2], v1[3]); }
                    *(u32x4*)(rowp + bj * HALF) = w; } }
    }
};
template <int KIND> struct EpiRes {
    static constexpr bool PERM = false, AFTER_DRAIN = false;
    float* out; const float* xp; const float* xs; const bf16_t* rb; float alpha, scale;
    __device__ __forceinline__ void operator()(const f32x4 (&acc)[2][2][4][2], const Unit& u, int wr, int wc, int fr, int fq) const {
        typedef unsigned u32x2v __attribute__((ext_vector_type(2)));
        const int row0 = u.pm * BM + wr * 64 + fr, col0 = u.pn * BM + wc * 32 + 4 * fq;
#pragma unroll
        for (int ai = 0; ai < 2; ++ai)
#pragma unroll
            for (int m = 0; m < 4; ++m) { const int r = row0 + ai * HALF + m * 16;
                const float* xr = (KIND == 0) ? ((r < 32768) ? xp + (size_t)r * 1024 : xs + (size_t)(r - 32768) * 1024) : nullptr;
#pragma unroll
                for (int bj = 0; bj < 2; ++bj)
#pragma unroll
                    for (int n = 0; n < 2; ++n) { const int c = col0 + bj * HALF + n * 16; f32x4 rs;
                        if (KIND == 0) rs = *(const f32x4*)(xr + c);
                        else { const u32x2v q = *(const u32x2v*)(rb + (size_t)r * 1024 + c);
                            rs[0] = __uint_as_float(q.x << 16); rs[1] = __uint_as_float(q.x & 0xffff0000u); rs[2] = __uint_as_float(q.y << 16); rs[3] = __uint_as_float(q.y & 0xffff0000u); }
                        *(f32x4*)(out + (size_t)r * 1024 + c) = rs * alpha + acc[ai][bj][m][n] * scale; }
                asm volatile("" ::: "memory"); }
    }
};

template <class Epi, class Sched, bool ALIGN_EPI = false, bool SP2 = false>
__device__ __forceinline__ void gemm_phase(PG8_LAS unsigned char* lds, const Gemm g, const Sched& S, const Epi& E) {
    const int tid = threadIdx.x, wid = __builtin_amdgcn_readfirstlane(tid >> 6), lane = tid & 63, wr = wid >> 2, wc = wid & 3, fr = lane & 15, fq = lane >> 4;
    const int K = g.K, nt = K / BK;
    unsigned voffA[2], voffB[2];
#pragma unroll
    for (int i = 0; i < 2; ++i) { int R, C; stage_rc(tid * 16 + i * 8192, R, C); const int Rb = Epi::PERM ? ((R & ~31) + perm32(R & 31)) : R;
        voffA[i] = (unsigned)(R * K + C) * 2u; voffB[i] = (unsigned)(Rb * K + C) * 2u; }
    const size_t kstep = (size_t)(BK * 2);
    const size_t hstep = (size_t)HALF * K * 2;
    const size_t tstep = 2 * hstep;
    const unsigned ldsw = (unsigned)wid * 1024u;
    const int aoff = lds_byte(wr * 64 + fr, fq * 8), boff = lds_byte(wc * 32 + fr, fq * 8);
#define PG8_SA(b, h) (((b) * 2 + (h)) * HTB)
#define PG8_SB(b, h) ((4 + (b) * 2 + (h)) * HTB)
#define PG8_STAGE(bufoff, gbase, voff) do { _Pragma("unroll") for (int _i = 0; _i < 2; ++_i) \
        __builtin_amdgcn_global_load_lds((const unsigned*)((const char*)(gbase) + (voff)[_i]), (PG8_LAS unsigned*)(lds + (bufoff) + ldsw + _i * 8192), 16, 0, 0); } while (0)
#define PG8_LDA(dst, b, h) do { _Pragma("unroll") for (int m = 0; m < 4; ++m) _Pragma("unroll") for (int k = 0; k < 2; ++k) dst[m][k] = *(const PG8_LAS bf16x8*)(lds + PG8_SA(b, h) + aoff + m * 2048 + k * 1024); } while (0)
#define PG8_LDB(dst, b, h) do { _Pragma("unroll") for (int n = 0; n < 2; ++n) _Pragma("unroll") for (int k = 0; k < 2; ++k) dst[n][k] = *(const PG8_LAS bf16x8*)(lds + PG8_SB(b, h) + boff + n * 2048 + k * 1024); } while (0)
#define PG8_MMA(ai, bj, At, Bt) do { __builtin_amdgcn_s_setprio(1); _Pragma("unroll") for (int m = 0; m < 4; ++m) _Pragma("unroll") for (int n = 0; n < 2; ++n) _Pragma("unroll") for (int k = 0; k < 2; ++k) \
        acc[ai][bj][m][n] = __builtin_amdgcn_mfma_f32_16x16x32_bf16(Bt[n][k], At[m][k], acc[ai][bj][m][n], 0, 0, 0); __builtin_amdgcn_s_setprio(0); } while (0)
#define PG8_WAIT_V(n) asm volatile("s_waitcnt vmcnt(" #n ")" ::: "memory")
#define PG8_WAIT_L(n) asm volatile("s_waitcnt lgkmcnt(" #n ")" ::: "memory")
#define PG8_BAR __builtin_amdgcn_s_barrier()
#define PG8_SCHED __builtin_amdgcn_sched_barrier(0)
    Unit cur, nxt; int ui = 0;
    if (!S.next(0, cur)) return;
    f32x4 acc[2][2][4][2];
#pragma unroll
    for (int a = 0; a < 2; ++a)
#pragma unroll
        for (int b = 0; b < 2; ++b)
#pragma unroll
            for (int m = 0; m < 4; ++m)
#pragma unroll
                for (int n = 0; n < 2; ++n) acc[a][b][m][n] = (f32x4){0.f, 0.f, 0.f, 0.f};
    bf16x8 At[4][2], B0[2][2], B1[2][2];
    const char* cA = (const char*)g.A + (size_t)cur.pm * tstep; const char* cB = (const char*)g.Bt + (size_t)cur.pn * tstep;
    S.a_ready(cur);
    if constexpr (SP2) {
        PG8_STAGE(PG8_SB(0, 0), cB, voffB); PG8_STAGE(PG8_SB(0, 1), cB + hstep, voffB); PG8_STAGE(PG8_SA(0, 0), cA, voffA); PG8_STAGE(PG8_SA(0, 1), cA + hstep, voffA);
        if (wr == 1) PG8_BAR;
        PG8_WAIT_V(2); PG8_BAR;
        PG8_STAGE(PG8_SB(1, 0), cB + kstep, voffB); PG8_STAGE(PG8_SA(1, 0), cA + kstep, voffA); PG8_STAGE(PG8_SB(1, 1), cB + hstep + kstep, voffB);
        PG8_WAIT_V(6); PG8_BAR;
    } else {
        PG8_STAGE(PG8_SB(0, 0), cB, voffB); PG8_STAGE(PG8_SA(0, 0), cA, voffA); PG8_STAGE(PG8_SB(0, 1), cB + hstep, voffB); PG8_STAGE(PG8_SA(0, 1), cA + hstep, voffA);
        if (wr == 1) PG8_BAR;
        PG8_WAIT_V(4); PG8_BAR;
        PG8_STAGE(PG8_SB(1, 0), cB + kstep, voffB); PG8_STAGE(PG8_SA(1, 0), cA + kstep, voffA); PG8_STAGE(PG8_SB(1, 1), cB + hstep + kstep, voffB);
        PG8_WAIT_V(6); PG8_BAR;
    }
    for (;;) {
        const bool has_next = S.next(ui + 1, nxt);
        const char* nA = has_next ? (const char*)g.A + (size_t)nxt.pm * tstep : cA; const char* nB = has_next ? (const char*)g.Bt + (size_t)nxt.pn * tstep : cB;
        for (int t = 0; t < nt; t += 2) {
            const bool last = (t == nt - 2);
            const char* a1 = cA + (size_t)(t + 1) * kstep;
            const char* a2 = last ? nA : cA + (size_t)(t + 2) * kstep; const char* b2 = last ? nB : cB + (size_t)(t + 2) * kstep;
            const char* a3 = a2 + kstep; const char* b3 = b2 + kstep;
            if (last && has_next) S.a_ready(nxt);
            if constexpr (SP2) {
            PG8_LDB(B0, 0, 0); PG8_LDB(B1, 0, 1); PG8_SCHED; PG8_LDA(At, 0, 0); PG8_STAGE(PG8_SA(1, 1), a1 + hstep, voffA);
            PG8_WAIT_V(8); PG8_WAIT_L(0); PG8_BAR; PG8_MMA(0, 0, At, B0); PG8_MMA(0, 1, At, B1); PG8_BAR; PG8_SCHED;
            PG8_LDA(At, 0, 1); PG8_STAGE(PG8_SB(0, 0), b2, voffB); PG8_STAGE(PG8_SB(0, 1), b2 + hstep, voffB); PG8_STAGE(PG8_SA(0, 0), a2, voffA);
            PG8_WAIT_V(8); PG8_WAIT_L(0); PG8_BAR; PG8_MMA(1, 0, At, B0); PG8_MMA(1, 1, At, B1); PG8_BAR; PG8_SCHED;
            PG8_LDB(B0, 1, 0); PG8_LDB(B1, 1, 1); PG8_SCHED; PG8_LDA(At, 1, 0); PG8_STAGE(PG8_SA(0, 1), a2 + hstep, voffA);
            PG8_WAIT_V(8); PG8_WAIT_L(0); PG8_BAR; PG8_MMA(0, 0, At, B0); PG8_MMA(0, 1, At, B1); PG8_BAR; PG8_SCHED;
            PG8_LDA(At, 1, 1); PG8_STAGE(PG8_SB(1, 0), b3, voffB); PG8_STAGE(PG8_SB(1, 1), b3 + hstep, voffB); PG8_STAGE(PG8_SA(1, 0), a3, voffA);
            PG8_WAIT_V(8); PG8_WAIT_L(0); PG8_BAR; PG8_MMA(1, 0, At, B0); PG8_MMA(1, 1, At, B1); PG8_BAR; PG8_SCHED;
            } else {
            PG8_LDB(B0, 0, 0); PG8_SCHED; PG8_LDA(At, 0, 0); PG8_STAGE(PG8_SA(1, 1), a1 + hstep, voffA);
            PG8_WAIT_L(8); PG8_BAR; PG8_WAIT_L(0); PG8_MMA(0, 0, At, B0); PG8_BAR; PG8_SCHED;
            PG8_LDB(B1, 0, 1); PG8_STAGE(PG8_SB(0, 0), b2, voffB);
            PG8_BAR; PG8_WAIT_L(0); PG8_MMA(0, 1, At, B1); PG8_BAR;
            PG8_LDA(At, 0, 1); PG8_STAGE(PG8_SA(0, 0), a2, voffA);
            PG8_BAR; PG8_WAIT_L(0); PG8_MMA(1, 0, At, B0); PG8_BAR; PG8_SCHED;
            PG8_STAGE(PG8_SB(0, 1), b2 + hstep, voffB);
            PG8_WAIT_V(6); PG8_BAR; PG8_MMA(1, 1, At, B1); PG8_BAR;
            PG8_LDB(B0, 1, 0); PG8_SCHED; PG8_LDA(At, 1, 0); PG8_STAGE(PG8_SA(0, 1), a2 + hstep, voffA);
            PG8_WAIT_L(8); PG8_BAR; PG8_WAIT_L(0); PG8_MMA(0, 0, At, B0); PG8_BAR; PG8_SCHED;
            PG8_LDB(B1, 1, 1); PG8_STAGE(PG8_SB(1, 0), b3, voffB);
            PG8_BAR; PG8_WAIT_L(0); PG8_MMA(0, 1, At, B1); PG8_BAR;
            PG8_LDA(At, 1, 1); PG8_STAGE(PG8_SA(1, 0), a3, voffA);
            PG8_BAR; PG8_WAIT_L(0); PG8_MMA(1, 0, At, B0); PG8_BAR; PG8_SCHED;
            PG8_STAGE(PG8_SB(1, 1), b3 + hstep, voffB);
            PG8_WAIT_V(6); PG8_BAR; PG8_MMA(1, 1, At, B1); PG8_BAR;
            }
        }
        if constexpr (ALIGN_EPI) { if (wr == 0) PG8_BAR; }
        if constexpr (!Epi::AFTER_DRAIN) { E(acc, cur, wr, wc, fr, fq); S.done(cur); }
        if (!has_next) break;
#pragma unroll
        for (int a = 0; a < 2; ++a)
#pragma unroll
            for (int b = 0; b < 2; ++b)
#pragma unroll
                for (int m = 0; m < 4; ++m)
#pragma unroll
                    for (int n = 0; n < 2; ++n) acc[a][b][m][n] = (f32x4){0.f, 0.f, 0.f, 0.f};
        cur = nxt; cA = nA; cB = nB; ++ui;
        if constexpr (ALIGN_EPI) { if (wr == 1) PG8_BAR; }
    }
    PG8_WAIT_V(0);
    if constexpr (!ALIGN_EPI) { if (wr == 0) PG8_BAR; }
    PG8_BAR;
    if constexpr (Epi::AFTER_DRAIN) { E.fused(acc, cur, wr, wc, fr, fq, lds, wid, lane); S.done(cur); }
#undef PG8_SA
#undef PG8_SB
#undef PG8_STAGE
#undef PG8_LDA
#undef PG8_LDB
#undef PG8_MMA
#undef PG8_WAIT_V
#undef PG8_WAIT_L
#undef PG8_BAR
#undef PG8_SCHED
}
}
#define GAS __attribute__((address_space(1)))
#define LAS __attribute__((address_space(3)))
typedef unsigned short bf16;
typedef unsigned v4u __attribute__((ext_vector_type(4)));
typedef float f32x4 __attribute__((ext_vector_type(4)));
typedef short bf16x8 __attribute__((ext_vector_type(8)));
typedef GAS unsigned gu32;
typedef GAS unsigned long long gu64;
#define RLX_AGENT __ATOMIC_RELAXED, __HIP_MEMORY_SCOPE_AGENT
#define LDS_WAIT() asm volatile("s_waitcnt lgkmcnt(0)" ::: "memory")
#define VM_WAIT() asm volatile("s_waitcnt vmcnt(0)" ::: "memory")
__device__ __forceinline__ unsigned long long rt() { return __builtin_amdgcn_s_memrealtime(); }
__device__ __forceinline__ unsigned f2bf(float f) { unsigned u = __builtin_bit_cast(unsigned, f); return (u + 0x7fffu + ((u >> 16) & 1u)) >> 16; }
__device__ __forceinline__ unsigned pk2(float lo, float hi) { return f2bf(lo) | (f2bf(hi) << 16); }

#define XB_TMO      128
#define XB_XCNT(j)  (256  + 64 * (j))
#define XB_XSUB(j)  (1280 + 64 * (j))
#define XB_XGEN(j)  (2304 + 64 * (j))
#define XB_TOP      3328
#define XB_TOPGEN   3392
#define XCD_BAR_WORDS 3456
#define XB_SPIN_CAP (1u << 18)

__device__ __forceinline__ unsigned xb_ld(unsigned* p)              { return __hip_atomic_load(p, __ATOMIC_RELAXED, __HIP_MEMORY_SCOPE_AGENT); }
__device__ __forceinline__ unsigned xb_add(unsigned* p, unsigned v) { return __hip_atomic_fetch_add(p, v, __ATOMIC_RELAXED, __HIP_MEMORY_SCOPE_AGENT); }
__device__ __forceinline__ unsigned xb_xcc_id() { return (unsigned)__builtin_amdgcn_s_getreg((3 << 11) | 20) & 0xFu; }
#define XB_SPIN(cond, bar) do { unsigned _sp = 0; while (cond) { __builtin_amdgcn_s_sleep(1); \
    if ((++_sp & 255u) == 0u) { if (xb_ld(&(bar)[XB_TMO])) break; if (_sp > XB_SPIN_CAP) { atomicAdd(&(bar)[XB_TMO], 1u); break; } } } } while (0)

struct XcdBarrier {
    unsigned* bar; unsigned x;
    volatile LAS unsigned* st;
};

__device__ __forceinline__ XcdBarrier xcd_barrier_post(unsigned* bar, volatile LAS unsigned* st) {
    XcdBarrier b; b.bar = bar; b.x = xb_xcc_id(); b.st = st;
    if (threadIdx.x == 0) (void)xb_add(&bar[XB_XCNT(b.x)], 1u);
    return b;
}
__device__ __forceinline__ void xcd_barrier_complete(unsigned* bar, unsigned x, unsigned& nloc, unsigned& nx) {
    const unsigned G = gridDim.x * gridDim.y * gridDim.z;
    unsigned sum, cnt, mine, sp = 0u;
    for (;;) {
        sum = 0u; cnt = 0u; mine = 0u;
#pragma unroll
        for (unsigned j = 0; j < 16; ++j) { const unsigned c = xb_ld(&bar[XB_XCNT(j)]); sum += c; cnt += (c > 0u) ? 1u : 0u; mine = (j == x) ? c : mine; }
        if (sum == G) break;
        __builtin_amdgcn_s_sleep(1);
        if ((++sp & 255u) == 0u) { if (xb_ld(&bar[XB_TMO])) break; if (sp > XB_SPIN_CAP) { atomicAdd(&bar[XB_TMO], 1u); break; } }
    }
    nloc = mine > 0u ? mine : 1u; nx = cnt > 0u ? cnt : 1u;
}

__device__ __forceinline__ void xcd_barrier(const XcdBarrier& b) {
    asm volatile("s_waitcnt vmcnt(0)" ::: "memory");
    __syncthreads();
    if (threadIdx.x == 0) {
        unsigned* bar = b.bar;
        __builtin_amdgcn_s_waitcnt(0);
        unsigned nloc = b.st[0], nx = b.st[1];
        if (nloc == 0u) { xcd_barrier_complete(bar, b.x, nloc, nx); b.st[0] = nloc; b.st[1] = nx; }
        const unsigned old = xb_add(&bar[XB_XSUB(b.x)], 1u);
        const unsigned gen = old / nloc;
        if (old + 1u == (gen + 1u) * nloc) {
            __builtin_amdgcn_fence(__ATOMIC_RELEASE, "agent");
            asm volatile("s_waitcnt vmcnt(0)" ::: "memory");
            const unsigned og = xb_add(&bar[XB_TOP], 1u);
            const unsigned tg = og / nx;
            if (og + 1u == (tg + 1u) * nx) xb_add(&bar[XB_TOPGEN], 1u);
            else XB_SPIN(xb_ld(&bar[XB_TOPGEN]) == tg, bar);
            __builtin_amdgcn_fence(__ATOMIC_ACQUIRE, "agent");
            xb_add(&bar[XB_XGEN(b.x)], 1u);
            asm volatile("s_waitcnt vmcnt(0)" ::: "memory");
        } else {
            XB_SPIN(xb_ld(&bar[XB_XGEN(b.x)]) == gen, bar);
            __builtin_amdgcn_fence(__ATOMIC_ACQUIRE, "agent");
            asm volatile("s_waitcnt vmcnt(0)" ::: "memory");
        }
    }
    __syncthreads();
}

constexpr int NWAVES = 8;
constexpr int MTOT = 33792, MP = 32768, DM = 1024, DFF = 2816, DIN = 2816, SEQ = 2048;
constexpr float ALPHA = 1.189207115002721f, LOG2E = 1.4426950408889634f;
constexpr size_t MiB = 1u << 20;
constexpr size_t WS_CTL = 0, CTL_ZERO_BYTES = 1 * MiB, WS_LB = 1 * MiB;
constexpr size_t WS_W13A = 2 * MiB, WS_W2A = 13 * MiB, WS_WIN = 19 * MiB, WS_WOUT = 25 * MiB, WS_W13B = 27 * MiB, WS_W2B = 38 * MiB;
constexpr size_t WS_XB = 44 * MiB;
constexpr size_t WS_HP = 110 * MiB;
constexpr size_t WS_X1 = 292 * MiB;
constexpr size_t WS_ST = 358 * MiB;
constexpr size_t WS_END = 424 * MiB;
constexpr int CW_TMO = 0, CW_CODE = 1, CW_BAR = 4096;
constexpr size_t OY = 0, OYS = 33554432, OSP = 34603008, OKP = 35651584, OVP = 35913728, OSS = 36175872, OKS = 44564480, OVS = 46661632;
constexpr int RING_OFF = 0, RING_BYTES = 131072, LDSCTL_OFF = RING_BYTES, MISC_OFF = LDSCTL_OFF + 320, XS_OFF = RING_BYTES + 1024, LDS_BYTES = 147456;

typedef unsigned u32x2 __attribute__((ext_vector_type(2)));
typedef short s16x4 __attribute__((ext_vector_type(4)));
typedef float f32x2 __attribute__((ext_vector_type(2)));
typedef _Float16 f16x2 __attribute__((ext_vector_type(2)));

struct Frame {
    LAS unsigned char* lds; volatile LAS unsigned* MISC; gu32* ctl;
    int tid, lane, wave, vcu, G;
};
__device__ __forceinline__ float bflo(unsigned w) { return __uint_as_float(w << 16); }
__device__ __forceinline__ float bfhi(unsigned w) { return __uint_as_float(w & 0xffff0000u); }
__device__ __forceinline__ unsigned pkbf(float lo, float hi) { return pg8::cvt_pk_bf16(lo, hi); }
__device__ __forceinline__ s16x4 ds_tr16(LAS const unsigned char* p) { return __builtin_bit_cast(s16x4, __builtin_amdgcn_ds_read_tr16_b64_v4i16((LAS s16x4*)p)); }
__device__ __forceinline__ bf16x8 cat4(s16x4 a, s16x4 b) { return (bf16x8){a[0], a[1], a[2], a[3], b[0], b[1], b[2], b[3]}; }
__device__ __forceinline__ bf16x8 pack8(f32x4 a, f32x4 b) { v4u w; w.x = pkbf(a[0], a[1]); w.y = pkbf(a[2], a[3]); w.z = pkbf(b[0], b[1]); w.w = pkbf(b[2], b[3]); return __builtin_bit_cast(bf16x8, w); }
__device__ __forceinline__ f32x4 mfma16(bf16x8 a, bf16x8 b, f32x4 c) { return __builtin_amdgcn_mfma_f32_16x16x32_bf16(a, b, c, 0, 0, 0); }
__device__ __forceinline__ int off256(int row, int k) { return row * 256 + ((((k >> 3) ^ (row & 15))) << 4) + (k & 7) * 2; }

__device__ __forceinline__ float wave_sum(float v) {
#pragma unroll
    for (int o = 1; o < 64; o <<= 1) v += __shfl_xor(v, o);
    return v;
}
__device__ __forceinline__ void p0_transpose_item(const float* W, int K, int ldw, int Ndst, bf16* WT, int mode, LAS float* scr, int item, int lane) {
    const int nblk = Ndst / 32, kb = item / nblk, nb = item % nblk, k0 = 64 * kb, n0 = 32 * nb;
    const int c0 = (mode == 1) ? (((n0 >> 7) & 1) * 2816 + (n0 >> 8) * 128 + (n0 & 127)) : n0;
#pragma unroll 8
    for (int i = 0; i < 32; ++i) { const int kk = 2 * i + (lane >> 5); scr[kk * 33 + (lane & 31)] = W[(size_t)(k0 + kk) * ldw + c0 + (lane & 31)]; }
    LDS_WAIT(); asm volatile("" ::: "memory");
    const int c = lane & 7;
#pragma unroll
    for (int j = 0; j < 4; ++j) { const int n = (lane >> 3) + 8 * j; const LAS float* s = scr + (8 * c) * 33 + n;
        v4u o; o.x = pk2(s[0 * 33], s[1 * 33]); o.y = pk2(s[2 * 33], s[3 * 33]); o.z = pk2(s[4 * 33], s[5 * 33]); o.w = pk2(s[6 * 33], s[7 * 33]);
        *(GAS v4u*)(WT + (size_t)(n0 + n) * K + k0 + 8 * c) = o; }
    LDS_WAIT(); asm volatile("" ::: "memory");
}
struct Ptrs {
    const float *xp, *xs, *st0, *ck, *cv, *ln1g, *ln1b, *w13a, *w2a, *win, *lbp, *sink, *ang, *hng, *wout, *ln2g, *ln2b, *w13b, *w2b, *ln3g, *ln3b;
    float* out; float* LB;
    bf16 *W13A, *W2A, *WIN, *WOUT, *W13B, *W2B, *XB, *HP, *X1, *ST, *X2, *MIX;
};
__device__ __forceinline__ void p0_prologue(Frame& F, const Ptrs& P) {
    LAS float* scr = (LAS float*)(F.lds + RING_OFF + F.wave * 16384);
    const int gw = F.vcu * NWAVES + F.wave, NGW = F.G * NWAVES;
    constexpr int I13 = 16 * 176, I2 = 44 * 32, IIN = 16 * 88, IOUT = 16 * 32;
    constexpr int NITEMS = 2 * I13 + 2 * I2 + IIN + IOUT;
    for (int it = gw; it < NITEMS; it += NGW) {
        int r = it;
        if (r < I13) { p0_transpose_item(P.w13a, 1024, 5632, 5632, P.W13A, 1, scr, r, F.lane); continue; } r -= I13;
        if (r < I13) { p0_transpose_item(P.w13b, 1024, 5632, 5632, P.W13B, 1, scr, r, F.lane); continue; } r -= I13;
        if (r < I2) { p0_transpose_item(P.w2a, 2816, 1024, 1024, P.W2A, 0, scr, r, F.lane); continue; } r -= I2;
        if (r < I2) { p0_transpose_item(P.w2b, 2816, 1024, 1024, P.W2B, 0, scr, r, F.lane); continue; } r -= I2;
        if (r < IIN) { p0_transpose_item(P.win, 1024, 2816, 2816, P.WIN, 0, scr, r, F.lane); continue; } r -= IIN;
        p0_transpose_item(P.wout, 1024, 1024, 1024, P.WOUT, 0, scr, r, F.lane);
    }
    for (int m = gw; m < MTOT; m += NGW) {
        const float* xr = (m < MP) ? P.xp + (size_t)m * DM : P.xs + (size_t)(m - MP) * DM;
        const GAS f32x4* xv = (const GAS f32x4*)xr + F.lane; GAS u32x2* o8 = (GAS u32x2*)(P.XB + (size_t)m * DM) + F.lane;
#pragma unroll
        for (int j = 0; j < 4; ++j) { const f32x4 v = xv[64 * j]; u32x2 w; w.x = pkbf(v[0], v[1]); w.y = pkbf(v[2], v[3]); o8[64 * j] = w; }
    }
    if (F.vcu == 0) { const float p0 = P.lbp[F.tid], p1 = P.lbp[512 + F.tid]; P.LB[F.tid] = 1.f / (1.f + __expf(p1 - p0)); }
}
template <bool F32OUT> __device__ __forceinline__ void ln_pass(Frame& F, const float* V, bf16* Xo, float* Yo, const float* gam, const float* bet) {
    const int gw = F.vcu * NWAVES + F.wave, NGW = F.G * NWAVES;
    f32x4 gv[4], bv[4];
#pragma unroll
    for (int j = 0; j < 4; ++j) { gv[j] = *((const f32x4*)gam + F.lane + 64 * j); bv[j] = *((const f32x4*)bet + F.lane + 64 * j); }
    for (int m = gw; m < MTOT; m += NGW) {
        const GAS f32x4* xr = (const GAS f32x4*)(V + (size_t)m * DM) + F.lane;
        f32x4 v[4]; float s = 0.f;
#pragma unroll
        for (int j = 0; j < 4; ++j) { v[j] = xr[64 * j]; s += (v[j][0] + v[j][1]) + (v[j][2] + v[j][3]); }
        const float mean = wave_sum(s) * (1.f / DM); float s2 = 0.f;
#pragma unroll
        for (int j = 0; j < 4; ++j) { v[j] = v[j] - mean; s2 += (v[j][0] * v[j][0] + v[j][1] * v[j][1]) + (v[j][2] * v[j][2] + v[j][3] * v[j][3]); }
        const float rstd = 1.f / sqrtf(wave_sum(s2) * (1.f / DM) + 1e-5f);
#pragma unroll
        for (int j = 0; j < 4; ++j) { const f32x4 o = v[j] * rstd * gv[j] + bv[j];
            if (F32OUT) *((GAS f32x4*)(Yo + (size_t)m * DM) + F.lane + 64 * j) = o;
            else { u32x2 w; w.x = pkbf(o[0], o[1]); w.y = pkbf(o[2], o[3]); *((GAS u32x2*)(Xo + (size_t)m * DM) + F.lane + 64 * j) = w; } }
    }
}
template <bool SAMPLE>
__device__ __forceinline__ void attn_unit(Frame& F, const Ptrs& P, int b, int n) {
    LAS unsigned char* L = F.lds;
    const bf16* PROJ = P.HP;
    const int tid = F.tid, lane = F.lane, w = F.wave, fr = lane & 15, g = lane >> 4;
    if (!SAMPLE) {
        const long rowb = (long)b * SEQ + 128 * (n - 1);
#pragma unroll
        for (int i = 0; i < 16; ++i) { const int id = tid + 512 * i, key = id >> 5, c32 = id & 31;
            v4u v = (v4u){0u, 0u, 0u, 0u};
            if (n > 0 || key >= 128) v = *(const v4u*)(PROJ + (size_t)(rowb + key) * DIN + 512 + c32 * 8);
            *(LAS v4u*)(L + (c32 >> 3) * 32768 + key * 128 + (((c32 & 7) ^ (key & 7)) << 4)) = v; }
    } else {
#pragma unroll
        for (int i = 0; i < 9; ++i) { const int id = tid + 512 * i, key = id >> 5, c32 = id & 31, tile = c32 >> 3, kh = tile & 1, c8 = c32 & 7;
            v4u v = (v4u){0u, 0u, 0u, 0u};
            if (key < 128) { const float* src = ((tile < 2) ? P.ck : P.cv) + ((size_t)(b * 128 + key) * 2 + kh) * 64 + c8 * 8;
                const f32x4 a = *(const f32x4*)src, c = *(const f32x4*)(src + 4); v.x = pkbf(a[0], a[1]); v.y = pkbf(a[2], a[3]); v.z = pkbf(c[0], c[1]); v.w = pkbf(c[2], c[3]); }
            else if (key < 136) v = *(const v4u*)(PROJ + (size_t)(MP + 8 * b + key - 128) * DIN + 512 + c32 * 8);
            *(LAS v4u*)(L + tile * 32768 + key * 128 + ((c8 ^ (key & 7)) << 4)) = v; }
    }
    if (!SAMPLE) {
        if (n == 15) {
#pragma unroll
            for (int i = 0; i < 8; ++i) { const int id = tid + 512 * i, wr = id >> 5, c32 = id & 31;
                const v4u v = *(const v4u*)(PROJ + (size_t)(b * SEQ + 1920 + wr) * DIN + 512 + c32 * 8);
                float* dst = ((c32 < 16) ? P.out + OKP : P.out + OVP) + (size_t)(b * 128 + wr) * 128 + (c32 & 15) * 8;
                *(f32x4*)dst = (f32x4){bflo(v.x), bfhi(v.x), bflo(v.y), bfhi(v.y)}; *(f32x4*)(dst + 4) = (f32x4){bflo(v.z), bfhi(v.z), bflo(v.w), bfhi(v.w)}; }
        }
    } else {
#pragma unroll
        for (int i = 0; i < 15; ++i) { const int id = tid + 512 * i, which = id / 3840, rem = id % 3840, wr = rem >> 5, c4 = rem & 31;
            const f32x4 v = *(const f32x4*)((which ? P.cv : P.ck) + (size_t)(b * 128 + wr + 8) * 128 + c4 * 4);
            *(f32x4*)((which ? P.out + OVS : P.out + OKS) + (size_t)(b * 128 + wr) * 128 + c4 * 4) = v; }
        if (tid < 256) { const int wr = tid >> 5, c32 = tid & 31;
            const v4u v = *(const v4u*)(PROJ + (size_t)(MP + 8 * b + wr) * DIN + 512 + c32 * 8);
            float* dst = ((c32 < 16) ? P.out + OKS : P.out + OVS) + (size_t)(b * 128 + 120 + wr) * 128 + (c32 & 15) * 8;
            *(f32x4*)dst = (f32x4){bflo(v.x), bfhi(v.x), bflo(v.y), bfhi(v.y)}; *(f32x4*)(dst + 4) = (f32x4){bflo(v.z), bfhi(v.z), bflo(v.w), bfhi(v.w)}; }
    }
    __syncthreads();
    const int h = w, kh = h >> 2;
    const float slope2 = exp2f(-(float)(h + 1)) * LOG2E, sink2 = P.sink[h] * LOG2E, sc2 = 0.125f * LOG2E;
    LAS const unsigned char* Kt = L + kh * 32768; LAS const unsigned char* Vt = L + 65536 + kh * 32768;
    LAS float* SCR = (LAS float*)(L + XS_OFF);
    constexpr int NPASS = SAMPLE ? 1 : 2, QTP = SAMPLE ? 1 : 4;
    for (int pass = 0; pass < NPASS; ++pass) {
        f32x4 o[QTP][4]; float ssq[QTP];
        bf16x8 qfa[QTP][2];
#pragma unroll
        for (int q = 0; q < QTP; ++q) { const int qt = pass * 4 + q;
            long qrow; if (!SAMPLE) qrow = (long)b * SEQ + 128 * n + 16 * qt + fr; else qrow = MP + 8 * b + ((fr < 8) ? fr : 0);
#pragma unroll
            for (int kk = 0; kk < 2; ++kk) qfa[q][kk] = *(const bf16x8*)(PROJ + (size_t)qrow * DIN + h * 64 + 32 * kk + 8 * g); }
#pragma unroll
        for (int q = 0; q < QTP; ++q) {
            const int qt = pass * 4 + q;
            bf16x8 qf[2]; qf[0] = qfa[q][0]; qf[1] = qfa[q][1];
            f32x4 s[9];
#pragma unroll
            for (int i = 0; i < 9; ++i) { const int key = 16 * (qt + i) + fr; LAS const unsigned char* kp = Kt + key * 128;
                const bf16x8 k0 = *(LAS const bf16x8*)(kp + ((g ^ (key & 7)) << 4)), k1 = *(LAS const bf16x8*)(kp + (((g + 4) ^ (key & 7)) << 4));
                f32x4 a = (f32x4){0.f, 0.f, 0.f, 0.f}; a = mfma16(k0, qf[0], a); a = mfma16(k1, qf[1], a); s[i] = a; }
            float mx = -INFINITY;
#pragma unroll
            for (int i = 0; i < 9; ++i)
#pragma unroll
                for (int r = 0; r < 4; ++r) { const int dist = 128 + fr - 16 * i - 4 * g - r;
                    const bool valid = (dist >= 0) && (dist < 128) && (SAMPLE || n > 0 || (16 * (qt + i) + 4 * g + r) >= 128);
                    const float x = valid ? (s[i][r] * sc2 - slope2 * (float)dist) : -INFINITY; s[i][r] = x; mx = fmaxf(mx, x); }
            mx = fmaxf(mx, __shfl_xor(mx, 16)); mx = fmaxf(mx, __shfl_xor(mx, 32)); mx = fmaxf(mx, sink2);
            float sum = 0.f;
#pragma unroll
            for (int i = 0; i < 9; ++i)
#pragma unroll
                for (int r = 0; r < 4; ++r) { const float p = __builtin_amdgcn_exp2f(s[i][r] - mx); s[i][r] = p; sum += p; }
            sum += __shfl_xor(sum, 16); sum += __shfl_xor(sum, 32); sum += __builtin_amdgcn_exp2f(sink2 - mx);
            const float inv = 1.f / sum;
            bf16x8 pf[5];
#pragma unroll
            for (int ks = 0; ks < 4; ++ks) pf[ks] = pack8(s[2 * ks], s[2 * ks + 1]);
            pf[4] = pack8(s[8], (f32x4){0.f, 0.f, 0.f, 0.f});
            float sq = 0.f;
#pragma unroll
            for (int dt = 0; dt < 4; ++dt) { f32x4 acc = (f32x4){0.f, 0.f, 0.f, 0.f};
#pragma unroll
                for (int ks = 0; ks < 5; ++ks) { const int row1 = 16 * (qt + 2 * ks) + 4 * g + (fr >> 2), row2 = (ks < 4) ? row1 + 16 : row1, chunk = 2 * dt + ((fr & 3) >> 1), sub = (fr & 1) * 8;
                    const s16x4 a1 = ds_tr16(Vt + row1 * 128 + ((chunk ^ (row1 & 7)) << 4) + sub), a2 = ds_tr16(Vt + row2 * 128 + ((chunk ^ (row2 & 7)) << 4) + sub);
                    acc = mfma16(cat4(a1, a2), pf[ks], acc); }
                acc = acc * inv; o[q][dt] = acc; sq += (acc[0] * acc[0] + acc[1] * acc[1]) + (acc[2] * acc[2] + acc[3] * acc[3]); }
            sq += __shfl_xor(sq, 16); sq += __shfl_xor(sq, 32); ssq[q] = sq;
            if (g == 0) SCR[h * 64 + q * 16 + fr] = sq;
        }
        __syncthreads();
#pragma unroll
        for (int q = 0; q < QTP; ++q) {
            const int qt = pass * 4 + q; float tot = 0.f;
#pragma unroll
            for (int hh = 0; hh < 8; ++hh) tot += SCR[hh * 64 + q * 16 + fr];
            const float rms = __builtin_amdgcn_rsqf(tot * (1.f / 512.f) + 1e-6f);
            long qrow; bool qv = true; if (!SAMPLE) qrow = (long)b * SEQ + 128 * n + 16 * qt + fr; else { qv = fr < 8; qrow = MP + 8 * b + (qv ? fr : 0); }
#pragma unroll
            for (int dt = 0; dt < 4; ++dt) { const f32x4 gn = *(const f32x4*)(P.ang + h * 64 + 16 * dt + 4 * g); const f32x4 v = o[q][dt] * rms * gn;
                u32x2 wv; wv.x = pkbf(v[0], v[1]); wv.y = pkbf(v[2], v[3]);
                if (qv) *(u32x2*)(P.MIX + (size_t)qrow * DM + h * 64 + 16 * dt + 4 * g) = wv; }
        }
        __syncthreads();
    }
}
__device__ __forceinline__ void hgrn_state_chain(Frame& F, const Ptrs& P, int b, int h, int dvs) {
    LAS unsigned char* L = F.lds;
    const bf16* PROJ = P.HP;
    const int tid = F.tid, lane = F.lane, w = F.wave, fr = lane & 15, g = lane >> 4, kp = tid & 63, seg = w;
    const size_t rowb = (size_t)b * SEQ;
    LAS float* TOT = (LAS float*)(L + 20480); LAS float* DEC = (LAS float*)(L + 24576);
    unsigned lfA[8], lfB[8], lfC[8], lfD[8]; v4u vvA = (v4u){0u, 0u, 0u, 0u}, vvB = vvA, vvC = vvA, vvD = vvA;
#define HS_LOAD(c, LF, VV) do { const bf16* p_ = PROJ + (rowb + 64 * (c) + 8 * seg) * DIN + 1280 + 128 * h + 2 * kp; \
        _Pragma("unroll") for (int i_ = 0; i_ < 8; ++i_) LF[i_] = *(const unsigned*)(p_ + (size_t)i_ * DIN); \
        if (tid < 256) VV = *(const v4u*)(PROJ + (rowb + 64 * (c) + (tid >> 2)) * DIN + 1792 + 128 * h + 32 * dvs + 8 * (tid & 3)); } while (0)
    f32x4 acc[2]; acc[0] = (f32x4){0.f, 0.f, 0.f, 0.f}; acc[1] = (f32x4){0.f, 0.f, 0.f, 0.f};
    HS_LOAD(0, lfA, vvA); HS_LOAD(1, lfB, vvB); HS_LOAD(2, lfC, vvC);
#define HS_BODY(c, LF, VV, LFN, VVN) do { \
        if ((c) + 3 < 32) HS_LOAD((c) + 3, LFN, VVN); \
        float lf0[8], lf1[8], bl0[8], bl1[8]; float t0 = 0.f, t1 = 0.f; \
        _Pragma("unroll") for (int i = 0; i < 8; ++i) { const f16x2 hh = __builtin_bit_cast(f16x2, LF[i]); lf0[i] = (float)hh.x; lf1[i] = (float)hh.y; t0 += lf0[i]; t1 += lf1[i]; bl0[i] = t0; bl1[i] = t1; } \
        *(LAS f32x2*)(TOT + seg * 128 + 2 * kp) = (f32x2){t0, t1}; \
        if (tid < 256) *(LAS v4u*)(L + 16384 + (tid >> 2) * 64 + (tid & 3) * 16) = VV; \
        __syncthreads(); \
        float pre0 = 0.f, pre1 = 0.f, tot0 = 0.f, tot1 = 0.f; \
        _Pragma("unroll") for (int s2 = 0; s2 < 8; ++s2) { const f32x2 tv = *(LAS f32x2*)(TOT + s2 * 128 + 2 * kp); tot0 += tv.x; tot1 += tv.y; if (s2 < seg) { pre0 += tv.x; pre1 += tv.y; } } \
        _Pragma("unroll") for (int i = 0; i < 8; ++i) { const float k0 = (1.f - __expf(lf0[i])) * __expf(tot0 - (pre0 + bl0[i])), k1 = (1.f - __expf(lf1[i])) * __expf(tot1 - (pre1 + bl1[i])); \
            *(LAS unsigned*)(L + off256(8 * seg + i, 2 * kp)) = pkbf(k0, k1); } \
        if (seg == 0) *(LAS f32x2*)(DEC + 2 * kp) = (f32x2){__expf(tot0), __expf(tot1)}; \
        __syncthreads(); \
        _Pragma("unroll") for (int nt = 0; nt < 2; ++nt) { u32x2 sv; sv.x = pkbf(acc[nt][0], acc[nt][1]); sv.y = pkbf(acc[nt][2], acc[nt][3]); \
            *(u32x2*)(P.ST + ((((size_t)b * 32 + (c)) * 4 + h) * 128 + (32 * dvs + 16 * nt + fr)) * 128 + 16 * w + 4 * g) = sv; } \
        const f32x4 dv4 = *(LAS f32x4*)(DEC + 16 * w + 4 * g); \
        acc[0] = acc[0] * dv4; acc[1] = acc[1] * dv4; \
        _Pragma("unroll") for (int ks = 0; ks < 2; ++ks) { const int row1 = 32 * ks + 4 * g + (fr >> 2), row2 = row1 + 16, ck = 16 * w + 4 * (fr & 3); \
            const bf16x8 A = cat4(ds_tr16(L + off256(row1, ck)), ds_tr16(L + off256(row2, ck))); \
            _Pragma("unroll") for (int nt = 0; nt < 2; ++nt) { const int cv2 = (16 * nt + 4 * (fr & 3)) * 2; \
                const bf16x8 Bv = cat4(ds_tr16(L + 16384 + row1 * 64 + cv2), ds_tr16(L + 16384 + row2 * 64 + cv2)); \
                acc[nt] = mfma16(A, Bv, acc[nt]); } } \
        __syncthreads(); } while (0)
    for (int c0 = 0; c0 < 32; c0 += 4) {
        HS_BODY(c0, lfA, vvA, lfD, vvD); HS_BODY(c0 + 1, lfB, vvB, lfA, vvA); HS_BODY(c0 + 2, lfC, vvC, lfB, vvB); HS_BODY(c0 + 3, lfD, vvD, lfC, vvC);
    }
#undef HS_BODY
#undef HS_LOAD
#pragma unroll
    for (int nt = 0; nt < 2; ++nt)
#pragma unroll
        for (int r = 0; r < 4; ++r) P.out[OSP + (((size_t)b * 4 + h) * 128 + 16 * w + 4 * g + r) * 128 + 32 * dvs + 16 * nt + fr] = acc[nt][r];
}
__device__ __forceinline__ void hgrn_out_phase(Frame& F, const Ptrs& P) {
    LAS unsigned char* L = F.lds;
    const bf16* PROJ = P.HP;
    const int tid = F.tid, lane = F.lane, w = F.wave, fr = lane & 15, g = lane >> 4, kp = tid & 63, seg = w;
    LAS float* TOT = (LAS float*)(L + 65536); LAS float* SSQ = (LAS float*)(L + 69632);
    const int tt = w & 3, dh = w >> 2, t = 16 * tt + fr;
    unsigned qw[8], lfw[8]; v4u vch[2];
#define HO_LOAD(u_) do { const int b_ = (u_) >> 7, c_ = ((u_) >> 2) & 31, h_ = (u_) & 3; const size_t r_ = (size_t)b_ * SEQ + 64 * c_; \
        const bf16* p_ = PROJ + (r_ + 8 * seg) * DIN + 128 * h_ + 2 * kp; \
        _Pragma("unroll") for (int i_ = 0; i_ < 8; ++i_) { qw[i_] = *(const unsigned*)(p_ + (size_t)i_ * DIN + 768); lfw[i_] = *(const unsigned*)(p_ + (size_t)i_ * DIN + 1280); } \
        _Pragma("unroll") for (int j_ = 0; j_ < 2; ++j_) { const int id_ = tid + 512 * j_; vch[j_] = *(const v4u*)(PROJ + (r_ + (id_ >> 4)) * DIN + 1792 + 128 * h_ + 8 * (id_ & 15)); } } while (0)
    int u = F.vcu; if (u < 2048) HO_LOAD(u);
    for (; u < 2048; u += F.G) {
        const int b = u >> 7, c = (u >> 2) & 31, h = u & 3; const size_t row0 = (size_t)b * SEQ + 64 * c;
        const bf16* STu = P.ST + ((((size_t)b * 32 + c) * 4 + h) * 128) * 128;
        bf16x8 Sf[4][4]; u32x2 gt[4]; f32x4 gnv[4];
#pragma unroll
        for (int dvt = 0; dvt < 4; ++dvt) { const int dvb = 16 * (4 * dh + dvt);
#pragma unroll
            for (int kk = 0; kk < 4; ++kk) Sf[dvt][kk] = *(const bf16x8*)(STu + (size_t)(dvb + fr) * 128 + 8 * g + 32 * kk);
            gt[dvt] = *(const u32x2*)(PROJ + (row0 + t) * DIN + 2304 + 128 * h + dvb + 4 * g); gnv[dvt] = *(const f32x4*)(P.hng + 128 * h + dvb + 4 * g); }
#pragma unroll
        for (int j = 0; j < 2; ++j) { const int id = tid + 512 * j, row = id >> 4, ch = id & 15; *(LAS v4u*)(L + 49152 + row * 256 + ((ch ^ (row & 15)) << 4)) = vch[j]; }
        float lf0[8], lf1[8], bl0[8], bl1[8], q0[8], q1[8]; float t0 = 0.f, t1 = 0.f;
#pragma unroll
        for (int i = 0; i < 8; ++i) { const f16x2 hh = __builtin_bit_cast(f16x2, lfw[i]); lf0[i] = (float)hh.x; lf1[i] = (float)hh.y; t0 += lf0[i]; t1 += lf1[i]; bl0[i] = t0; bl1[i] = t1; q0[i] = bflo(qw[i]); q1[i] = bfhi(qw[i]); }
        *(LAS f32x2*)(TOT + seg * 128 + 2 * kp) = (f32x2){t0, t1};
        if (u + F.G < 2048) HO_LOAD(u + F.G);
        __syncthreads();
        float pre0 = 0.f, pre1 = 0.f, tot0 = 0.f, tot1 = 0.f;
#pragma unroll
        for (int s2 = 0; s2 < 8; ++s2) { const f32x2 tv = *(LAS f32x2*)(TOT + s2 * 128 + 2 * kp); tot0 += tv.x; tot1 += tv.y; if (s2 < seg) { pre0 += tv.x; pre1 += tv.y; } }
#pragma unroll
        for (int i = 0; i < 8; ++i) { const float b0 = pre0 + bl0[i], b1 = pre1 + bl1[i];
            const int o_ = off256(8 * seg + i, 2 * kp);
            *(LAS unsigned*)(L + o_) = pkbf(q0[i] * __expf(b0), q1[i] * __expf(b1));
            *(LAS unsigned*)(L + 16384 + o_) = pkbf(q0[i] * __expf(b0 - tot0), q1[i] * __expf(b1 - tot1));
            *(LAS unsigned*)(L + 32768 + o_) = pkbf((1.f - __expf(lf0[i])) * __expf(tot0 - b0), (1.f - __expf(lf1[i])) * __expf(tot1 - b1)); }
        __syncthreads();
        f32x4 at[4];
#pragma unroll
        for (int st = 0; st < 4; ++st) { f32x4 a = (f32x4){0.f, 0.f, 0.f, 0.f};
#pragma unroll
            for (int kk = 0; kk < 4; ++kk) { const bf16x8 Kf = *(LAS const bf16x8*)(L + 32768 + off256(16 * st + fr, 8 * g + 32 * kk)), Qf = *(LAS const bf16x8*)(L + 16384 + off256(t, 8 * g + 32 * kk));
                a = mfma16(Kf, Qf, a); }
#pragma unroll
            for (int r = 0; r < 4; ++r) if (16 * st + 4 * g + r > t) a[r] = 0.f;
            at[st] = a; }
        bf16x8 bfr[2]; bfr[0] = pack8(at[0], at[1]); bfr[1] = pack8(at[2], at[3]);
        bf16x8 qh[4];
#pragma unroll
        for (int kk = 0; kk < 4; ++kk) qh[kk] = *(LAS const bf16x8*)(L + off256(t, 8 * g + 32 * kk));
        f32x4 oo[4]; float sq = 0.f;
#pragma unroll
        for (int dvt = 0; dvt < 4; ++dvt) { const int dvb = 16 * (4 * dh + dvt); f32x4 o = (f32x4){0.f, 0.f, 0.f, 0.f};
#pragma unroll
            for (int ks = 0; ks < 2; ++ks) { const int row1 = 32 * ks + 4 * g + (fr >> 2), cc = dvb + 4 * (fr & 3);
                o = mfma16(cat4(ds_tr16(L + 49152 + off256(row1, cc)), ds_tr16(L + 49152 + off256(row1 + 16, cc))), bfr[ks], o); }
#pragma unroll
            for (int kk = 0; kk < 4; ++kk) o = mfma16(Sf[dvt][kk], qh[kk], o);
            oo[dvt] = o; sq += (o[0] * o[0] + o[1] * o[1]) + (o[2] * o[2] + o[3] * o[3]); }
        sq += __shfl_xor(sq, 16); sq += __shfl_xor(sq, 32);
        if (g == 0) SSQ[dh * 64 + t] = sq;
        __syncthreads();
        const float rms = __builtin_amdgcn_rsqf((SSQ[t] + SSQ[64 + t]) * (1.f / 128.f) + 1e-6f);
#pragma unroll
        for (int dvt = 0; dvt < 4; ++dvt) { const int dv = 16 * (4 * dh + dvt) + 4 * g;
            const f32x4 o = oo[dvt] * rms * gnv[dvt]; u32x2 wv; wv.x = pkbf(o[0] * bflo(gt[dvt].x), o[1] * bfhi(gt[dvt].x)); wv.y = pkbf(o[2] * bflo(gt[dvt].y), o[3] * bfhi(gt[dvt].y));
            *(u32x2*)(P.MIX + (row0 + t) * DM + 512 + 128 * h + dv) = wv; }
        __syncthreads();
    }
#undef HO_LOAD
}
__device__ __forceinline__ void hgrn_sample_unit(Frame& F, const Ptrs& P, int b, int h) {
    LAS unsigned char* L = F.lds;
    const unsigned short* PR = (const unsigned short*)P.HP;
    const int tid = F.tid, lane = F.lane, w = F.wave, dq = tid & 31, kr = tid >> 5;
    const size_t r0 = (size_t)MP + 8 * b;
    LAS float* REC = (LAS float*)L; LAS float* AM = (LAS float*)(L + 10240); LAS float* VS = (LAS float*)(L + 10496); LAS float* OP = (LAS float*)(L + 14592); LAS float* RSQ = (LAS float*)(L + 47360);
    const float* S0 = P.st0 + ((size_t)b * 4 + h) * 16384; float* S1 = P.out + OSS + ((size_t)b * 4 + h) * 16384;
    f32x4 s0[8];
#pragma unroll
    for (int p = 0; p < 8; ++p) s0[p] = *(const f32x4*)(S0 + (size_t)(16 * p + kr) * 128 + 4 * dq);
    f32x4 v4[8];
#pragma unroll
    for (int s = 0; s < 8; ++s) { const u32x2 q = *(const u32x2*)(PR + (r0 + s) * DIN + 1792 + 128 * h + 4 * dq); v4[s] = (f32x4){bflo(q.x), bfhi(q.x), bflo(q.y), bfhi(q.y)}; }
    if (tid < 128) { const int k = tid; float bb = 0.f, lf[8], q[8], bs[8];
#pragma unroll
        for (int t = 0; t < 8; ++t) { lf[t] = (float)__builtin_bit_cast(_Float16, PR[(r0 + t) * DIN + 1280 + 128 * h + k]); q[t] = __uint_as_float((unsigned)PR[(r0 + t) * DIN + 768 + 128 * h + k] << 16); }
#pragma unroll
        for (int t = 0; t < 8; ++t) { bb += lf[t]; bs[t] = bb; }
#pragma unroll
        for (int t = 0; t < 8; ++t) { REC[k * 20 + t] = q[t] * __expf(bs[t]); REC[k * 20 + 8 + t] = (1.f - __expf(lf[t])) * __expf(bb - bs[t]); }
        REC[k * 20 + 16] = __expf(bb); }
    if (kr == 0) {
#pragma unroll
        for (int s = 0; s < 8; ++s) *(LAS f32x4*)(VS + s * 128 + 4 * dq) = v4[s]; }
    __syncthreads();
    { const int p = tid >> 3, t = p >> 3, s = p & 7, part = tid & 7; float a = 0.f;
#pragma unroll 4
      for (int kk = 0; kk < 16; ++kk) { const int k = part * 16 + kk; a += REC[k * 20 + t] * REC[k * 20 + 8 + s] / REC[k * 20 + 16]; }
      a += __shfl_xor(a, 1); a += __shfl_xor(a, 2); a += __shfl_xor(a, 4);
      if (part == 0) AM[t * 8 + s] = (s <= t) ? a : 0.f; }
    f32x4 o[8];
#pragma unroll
    for (int t = 0; t < 8; ++t) o[t] = (f32x4){0.f, 0.f, 0.f, 0.f};
#pragma unroll
    for (int p = 0; p < 8; ++p) { const int k = 16 * p + kr;
        const f32x4 r0v = *(LAS f32x4*)(REC + k * 20), r1v = *(LAS f32x4*)(REC + k * 20 + 4), r2v = *(LAS f32x4*)(REC + k * 20 + 8), r3v = *(LAS f32x4*)(REC + k * 20 + 12); const float dec = REC[k * 20 + 16];
        const f32x4 sv = s0[p];
        o[0] += sv * r0v[0]; o[1] += sv * r0v[1]; o[2] += sv * r0v[2]; o[3] += sv * r0v[3]; o[4] += sv * r1v[0]; o[5] += sv * r1v[1]; o[6] += sv * r1v[2]; o[7] += sv * r1v[3];
        f32x4 sn = sv * dec;
        sn += v4[0] * r2v[0]; sn += v4[1] * r2v[1]; sn += v4[2] * r2v[2]; sn += v4[3] * r2v[3]; sn += v4[4] * r3v[0]; sn += v4[5] * r3v[1]; sn += v4[6] * r3v[2]; sn += v4[7] * r3v[3];
        *(f32x4*)(S1 + (size_t)k * 128 + 4 * dq) = sn; }
#pragma unroll
    for (int t = 0; t < 8; ++t) { f32x4 x = o[t];
#pragma unroll
        for (int j = 0; j < 4; ++j) x[j] += __shfl_xor(x[j], 32);
        if (lane < 32) *(LAS f32x4*)(OP + (w * 8 + t) * 128 + 4 * dq) = x; }
    __syncthreads();
    const int dv = tid & 127, tq = tid >> 7;
    float oe[2];
#pragma unroll
    for (int e = 0; e < 2; ++e) { const int t = 2 * tq + e; float x = 0.f;
#pragma unroll
        for (int ww = 0; ww < 8; ++ww) x += OP[(ww * 8 + t) * 128 + dv];
#pragma unroll
        for (int s = 0; s < 8; ++s) x += AM[t * 8 + s] * VS[s * 128 + dv];
        oe[e] = x; const float sq = wave_sum(x * x); if (lane == 0) RSQ[t * 2 + (w & 1)] = sq; }
    __syncthreads();
#pragma unroll
    for (int e = 0; e < 2; ++e) { const int t = 2 * tq + e; const float rms = __builtin_amdgcn_rsqf((RSQ[t * 2] + RSQ[t * 2 + 1]) * (1.f / 128.f) + 1e-6f);
        const float gate = __uint_as_float((unsigned)PR[(r0 + t) * DIN + 2304 + 128 * h + dv] << 16);
        const float y = oe[e] * rms * P.hng[128 * h + dv] * gate;
        ((unsigned short*)P.MIX)[(r0 + t) * DM + 512 + 128 * h + dv] = (unsigned short)(pkbf(y, 0.f) & 0xffffu); }
    __syncthreads();
}
#ifndef PG8_SP2
#define PG8_SP2 true
#endif
#ifndef PG8_ALIGN
#define PG8_ALIGN true
#endif
constexpr int NPH = 12;
struct Args { const float* in[21]; float* out; unsigned char* ws; int ph_lo, ph_hi, li, pad; };
__global__ void __launch_bounds__(NWAVES * 64, 2) mk_fwd(Args args) {
    extern __shared__ __attribute__((aligned(16))) unsigned char lds[];
    Frame F;
    F.lds = (LAS unsigned char*)lds;
    F.MISC = (volatile LAS unsigned*)(F.lds + MISC_OFF);
    F.tid = threadIdx.x; F.lane = F.tid & 63; F.wave = __builtin_amdgcn_readfirstlane(F.tid >> 6);
    F.G = gridDim.x; { const int bx = blockIdx.x; F.vcu = (F.G % 8 == 0) ? (bx % 8) * (F.G / 8) + bx / 8 : bx; }
    unsigned char* ws = args.ws;
    F.ctl = (gu32*)(ws + WS_CTL);
    Ptrs P;
    P.xp = args.in[0]; P.xs = args.in[1]; P.st0 = args.in[2]; P.ck = args.in[3]; P.cv = args.in[4]; P.ln1g = args.in[5]; P.ln1b = args.in[6]; P.w13a = args.in[7]; P.w2a = args.in[8];
    P.win = args.in[9]; P.lbp = args.in[10]; P.sink = args.in[11]; P.ang = args.in[12]; P.hng = args.in[13]; P.wout = args.in[14]; P.ln2g = args.in[15]; P.ln2b = args.in[16];
    P.w13b = args.in[17]; P.w2b = args.in[18]; P.ln3g = args.in[19]; P.ln3b = args.in[20];
    P.out = args.out; P.LB = (float*)(ws + WS_LB);
    P.W13A = (bf16*)(ws + WS_W13A); P.W2A = (bf16*)(ws + WS_W2A); P.WIN = (bf16*)(ws + WS_WIN); P.WOUT = (bf16*)(ws + WS_WOUT); P.W13B = (bf16*)(ws + WS_W13B); P.W2B = (bf16*)(ws + WS_W2B);
    P.XB = (bf16*)(ws + WS_XB); P.HP = (bf16*)(ws + WS_HP); P.X1 = (bf16*)(ws + WS_X1); P.ST = (bf16*)(ws + WS_ST); P.X2 = (bf16*)(ws + WS_ST); P.MIX = (bf16*)(ws + WS_XB);
    for (int u = F.tid; u < (LDS_BYTES - LDSCTL_OFF) / 4; u += NWAVES * 64) ((LAS unsigned*)(F.lds + LDSCTL_OFF))[u] = 0u;
    __syncthreads();
    const int lo = args.ph_lo, hi = args.ph_hi;
    XcdBarrier bar; bar.bar = (unsigned*)(F.ctl + CW_BAR) + args.li * XCD_BAR_WORDS; bar.x = 0; bar.st = nullptr;
    if (hi - lo > 1) bar = xcd_barrier_post((unsigned*)(F.ctl + CW_BAR) + args.li * XCD_BAR_WORDS, F.MISC + 8);
#ifndef MK_DOUBLE
#define MK_DOUBLE 0
#endif
#define IN(k) (lo <= (k) && (k) < hi)
#define REP(k) for (int rep_ = 0; rep_ < 1 + ((MK_DOUBLE >> (k)) & 1); ++rep_)
#define SEAM(k) do { if (IN(k) && IN((k) + 1)) xcd_barrier(bar); } while (0)
    float* V = P.out;
    if (IN(0)) { REP(0) { p0_prologue(F, P); } SEAM(0); }
    if (IN(1)) { REP(1) { pg8::Gemm g{P.XB, P.W13A, MTOT, 2 * DFF, DM}; pg8::StaticOrder S; S.init(MTOT, 2 * DFF, F.G, (int)blockIdx.x);
        pg8::EpiSwiGLU E{P.HP, DFF};
        pg8::gemm_phase<pg8::EpiSwiGLU, pg8::StaticOrder, PG8_ALIGN, PG8_SP2>(F.lds + RING_OFF, g, S, E); } SEAM(1); }
    if (IN(2)) { REP(2) { pg8::Gemm g{P.HP, P.W2A, MTOT, DM, DFF}; pg8::StaticOrder S; S.init(MTOT, DM, F.G, (int)blockIdx.x);
        pg8::EpiRes<0> E{V, P.xp, P.xs, nullptr, ALPHA, 0.5f};
        pg8::gemm_phase<pg8::EpiRes<0>, pg8::StaticOrder, PG8_ALIGN, PG8_SP2>(F.lds + RING_OFF, g, S, E); } SEAM(2); }
    if (IN(3)) { REP(3) { ln_pass<false>(F, V, P.X1, nullptr, P.ln1g, P.ln1b); } SEAM(3); }
    if (IN(4)) { REP(4) { pg8::Gemm g{P.X1, P.WIN, MTOT, DIN, DM}; pg8::StaticOrder S; S.init(MTOT, DIN, F.G, (int)blockIdx.x);
        pg8::EpiProj E{P.HP, DIN, P.LB};
        pg8::gemm_phase<pg8::EpiProj, pg8::StaticOrder, PG8_ALIGN, PG8_SP2>(F.lds + RING_OFF, g, S, E); } SEAM(4); }
    if (IN(5)) { REP(5) {
        const int cm = args.pad;
        if (cm & 1) for (int u = F.vcu; u < 256; u += F.G) hgrn_state_chain(F, P, u >> 4, (u >> 2) & 3, u & 3);
        if (cm & 2) for (int u = F.vcu; u < 256; u += F.G) attn_unit<false>(F, P, u >> 4, u & 15);
        if (cm & 4) for (int u = F.vcu; u < 128; u += F.G) attn_unit<true>(F, P, u, 0);
        if (cm & 8) for (int u = F.vcu; u < 512; u += F.G) hgrn_sample_unit(F, P, u >> 2, u & 3);
        } SEAM(5); }
    if (IN(6)) { REP(6) { hgrn_out_phase(F, P); } SEAM(6); }
    if (IN(7)) { REP(7) { pg8::Gemm g{P.MIX, P.WOUT, MTOT, DM, DM}; pg8::StaticOrder S; S.init(MTOT, DM, F.G, (int)blockIdx.x);
        pg8::EpiRes<1> E{V, nullptr, nullptr, P.X1, ALPHA, 1.0f};
        pg8::gemm_phase<pg8::EpiRes<1>, pg8::StaticOrder, PG8_ALIGN, PG8_SP2>(F.lds + RING_OFF, g, S, E); } SEAM(7); }
    if (IN(8)) { REP(8) { ln_pass<false>(F, V, P.X2, nullptr, P.ln2g, P.ln2b); } SEAM(8); }
    if (IN(9)) { REP(9) { pg8::Gemm g{P.X2, P.W13B, MTOT, 2 * DFF, DM}; pg8::StaticOrder S; S.init(MTOT, 2 * DFF, F.G, (int)blockIdx.x);
        pg8::EpiSwiGLU E{P.HP, DFF};
        pg8::gemm_phase<pg8::EpiSwiGLU, pg8::StaticOrder, PG8_ALIGN, PG8_SP2>(F.lds + RING_OFF, g, S, E); } SEAM(9); }
    if (IN(10)) { REP(10) { pg8::Gemm g{P.HP, P.W2B, MTOT, DM, DFF}; pg8::StaticOrder S; S.init(MTOT, DM, F.G, (int)blockIdx.x);
        pg8::EpiRes<1> E{V, nullptr, nullptr, P.X2, ALPHA, 0.5f};
        pg8::gemm_phase<pg8::EpiRes<1>, pg8::StaticOrder, PG8_ALIGN, PG8_SP2>(F.lds + RING_OFF, g, S, E); } SEAM(10); }
    if (IN(11)) { ln_pass<true>(F, V, nullptr, V, P.ln3g, P.ln3b); }
#undef IN
#undef SEAM
}
static int mk_grid() {
    static int grid = 0;
    if (grid == 0) {
        int dev = 0, cus = 0;
        if (hipGetDevice(&dev) != hipSuccess || hipDeviceGetAttribute(&cus, hipDeviceAttributeMultiprocessorCount, dev) != hipSuccess) { fprintf(stderr, "kernel_launch: device query failed\n"); grid = -1; return grid; }
        if (hipFuncSetAttribute((const void*)mk_fwd, hipFuncAttributeMaxDynamicSharedMemorySize, LDS_BYTES) != hipSuccess) { fprintf(stderr, "kernel_launch: hipFuncSetAttribute failed\n"); grid = -1; return grid; }
        int per_cu = 0;
        if (hipOccupancyMaxActiveBlocksPerMultiprocessor(&per_cu, (const void*)mk_fwd, NWAVES * 64, LDS_BYTES) != hipSuccess || per_cu < 1) fprintf(stderr, "kernel_launch: occupancy query reports %d\n", per_cu);
        (void)hipGetLastError();
        grid = cus;
    }
    return grid;
}
static void mk_launch(void* const* d_in, void* d_out, void* d_ws, hipStream_t stream, int lo, int hi, int li, int cmask = 15) {
    const int grid = mk_grid(); if (grid < 0) return;
    Args a{};
    for (int i = 0; i < 21; ++i) a.in[i] = (const float*)d_in[i];
    a.out = (float*)d_out; a.ws = (unsigned char*)d_ws; a.ph_lo = lo; a.ph_hi = hi; a.li = li; a.pad = cmask;
    hipLaunchKernelGGL(mk_fwd, dim3(grid), dim3(NWAVES * 64), LDS_BYTES, stream, a);
}
extern "C" void kernel_launch(void* const* d_in, const int* in_sizes, int n_in, void* d_out, int out_size, void* d_ws, size_t ws_size, hipStream_t stream) {
    if (ws_size < WS_END) { fprintf(stderr, "kernel_launch: workspace too small\n"); return; }
    (void)hipMemsetAsync((char*)d_ws + WS_CTL, 0, CTL_ZERO_BYTES, stream);
#ifndef MK_PROBE_MASK
#define MK_PROBE_MASK 15
#endif
#ifdef MK_PROBE_LO
    mk_launch(d_in, d_out, d_ws, stream, 0, MK_PROBE_HI, 0, MK_PROBE_MASK);
    mk_launch(d_in, d_out, d_ws, stream, MK_PROBE_LO, NPH, 1);
#else
    mk_launch(d_in, d_out, d_ws, stream, 0, NPH, 0);
#endif
}
```
